# Optimizing an MI355X kernel written in HIP

```python
import math
import jax, jax.numpy as jnp
from jax import lax
import numpy as np

D_MODEL = 2048
BATCH = 16
SEQ = 2048
DEPTH = 1

HEAD_DIM = 64
N_SWA_HEADS = 16
N_SWA_KV = 4
N_SB_HEADS = 16
WINDOW = 128
BLOCK = 128
D_FF = 5504
EPS = 1e-6

SWA_Q = N_SWA_HEADS * HEAD_DIM
SWA_KV = N_SWA_KV * HEAD_DIM
SB_W = N_SB_HEADS * HEAD_DIM
MIX_W = SWA_Q + SB_W
IN_W = SWA_Q + 2 * SWA_KV + 3 * SB_W

kernel_name = "hybrid_swa_sink_stickbreak_macaron"


def rmsnorm(x, g):
    xf = x.astype(jnp.float32)
    y = xf * lax.rsqrt(jnp.mean(xf * xf, axis=-1, keepdims=True) + EPS)
    return (y * g.astype(jnp.float32)).astype(x.dtype)


def swiglu(h, w_gate, w_up, w_down):
    return (jax.nn.silu(h @ w_gate) * (h @ w_up)) @ w_down


def alibi_slopes(n_heads):
    i = jnp.arange(1, n_heads + 1, dtype=jnp.float32)
    return jnp.exp2(-8.0 * i / n_heads)


def swa_sink_attention(q, k, v, sinks):
    B, S, H, D = q.shape
    Hkv = k.shape[2]
    G = H // Hkv
    nb = S // BLOCK
    qb = q.reshape(B, nb, BLOCK, Hkv, G, D)
    kb = k.reshape(B, nb, BLOCK, Hkv, D)
    vb = v.reshape(B, nb, BLOCK, Hkv, D)
    pad = ((0, 0), (1, 0), (0, 0), (0, 0), (0, 0))
    kk = jnp.concatenate([jnp.pad(kb[:, :-1], pad), kb], axis=2)
    vv = jnp.concatenate([jnp.pad(vb[:, :-1], pad), vb], axis=2)
    s = jnp.einsum('bnqhgd,bnkhd->bnhgqk', qb, kk).astype(jnp.float32) * (D ** -0.5)
    q_pos = jnp.arange(BLOCK)[:, None] + BLOCK
    k_pos = jnp.arange(2 * BLOCK)[None, :]
    dist = q_pos - k_pos
    valid = (dist >= 0) & (dist < WINDOW)
    blk = jnp.arange(nb)[:, None, None]
    valid = valid[None] & ((blk > 0) | (k_pos[None] >= BLOCK))
    slopes = alibi_slopes(H).reshape(Hkv, G)
    s = s - slopes[:, :, None, None] * dist.astype(jnp.float32)
    s = jnp.where(valid[None, :, None, None], s, -jnp.inf)
    sink = jnp.broadcast_to(sinks.astype(jnp.float32).reshape(1, 1, Hkv, G, 1, 1),
                            s.shape[:-1] + (1,))
    p = jax.nn.softmax(jnp.concatenate([s, sink], axis=-1), axis=-1)[..., :-1]
    o = jnp.einsum('bnhgqk,bnkhd->bnqhgd', p.astype(v.dtype), vv)
    return o.reshape(B, S, H * D)


def stick_breaking_attention(q, k, v):
    B, S, H, D = q.shape
    nb = S // BLOCK
    qb = q.reshape(B, nb, BLOCK, H, D).transpose(1, 0, 2, 3, 4)
    k_pos = jnp.arange(S)

    def one_block(args):
        q_blk, n = args
        z = jnp.einsum('bqhd,bkhd->bhqk', q_blk, k).astype(jnp.float32) * (D ** -0.5)
        q_pos = n * BLOCK + jnp.arange(BLOCK)
        mask = k_pos[None, :] < q_pos[:, None]
        log_beta = jax.nn.log_sigmoid(z)
        log_1m = jnp.where(mask, jax.nn.log_sigmoid(-z), 0.0)
        after = lax.cumsum(log_1m, axis=3, reverse=True) - log_1m
        a = jnp.where(mask, jnp.exp(log_beta + after), 0.0)
        return jnp.einsum('bhqk,bkhd->bqhd', a.astype(v.dtype), v)

    o = lax.map(one_block, (qb, jnp.arange(nb)))
    return o.transpose(1, 0, 2, 3, 4).reshape(B, S, H * D)


def setup_inputs(seed: int = 0) -> dict:
    key = jax.random.key(seed)
    ks = jax.random.split(key, 16)
    L = DEPTH

    def w(k, shape, fan_in):
        return jax.random.normal(k, shape, jnp.float32) * (fan_in ** -0.5)

    def gain(k, shape):
        return 1.0 + 0.02 * jax.random.normal(k, shape, jnp.float32)

    return {
        "x": jax.random.normal(ks[0], (BATCH, SEQ, D_MODEL), jnp.float32),
        "ffn1_norm": gain(ks[1], (L, D_MODEL)),
        "ffn1_w_gate": w(ks[2], (L, D_MODEL, D_FF), D_MODEL),
        "ffn1_w_up": w(ks[3], (L, D_MODEL, D_FF), D_MODEL),
        "ffn1_w_down": w(ks[4], (L, D_FF, D_MODEL), D_FF),
        "mix_norm": gain(ks[5], (L, D_MODEL)),
        "w_in": w(ks[6], (L, D_MODEL, IN_W), D_MODEL),
        "swa_sinks": jax.random.normal(ks[7], (L, N_SWA_HEADS), jnp.float32),
        "swa_out_norm": gain(ks[8], (L, SWA_Q)),
        "sb_out_norm": gain(ks[9], (L, SB_W)),
        "w_out": w(ks[10], (L, MIX_W, D_MODEL), MIX_W),
        "ffn2_norm": gain(ks[11], (L, D_MODEL)),
        "ffn2_w_gate": w(ks[12], (L, D_MODEL, D_FF), D_MODEL),
        "ffn2_w_up": w(ks[13], (L, D_MODEL, D_FF), D_MODEL),
        "ffn2_w_down": w(ks[14], (L, D_FF, D_MODEL), D_FF),
        "final_norm": gain(ks[15], (D_MODEL,)),
    }


def reference(x, ffn1_norm, ffn1_w_gate, ffn1_w_up, ffn1_w_down, mix_norm, w_in,
              swa_sinks, swa_out_norm, sb_out_norm, w_out, ffn2_norm, ffn2_w_gate,
              ffn2_w_up, ffn2_w_down, final_norm):
    B, S, _ = x.shape
    for l in range(DEPTH):
        x = x + 0.5 * swiglu(rmsnorm(x, ffn1_norm[l]), ffn1_w_gate[l], ffn1_w_up[l], ffn1_w_down[l])

        h = rmsnorm(x, mix_norm[l])
        proj = h @ w_in[l]
        o1 = SWA_Q
        o2 = o1 + SWA_KV
        o3 = o2 + SWA_KV
        o4 = o3 + SB_W
        o5 = o4 + SB_W
        qa = proj[..., :o1].reshape(B, S, N_SWA_HEADS, HEAD_DIM)
        ka = proj[..., o1:o2].reshape(B, S, N_SWA_KV, HEAD_DIM)
        va = proj[..., o2:o3].reshape(B, S, N_SWA_KV, HEAD_DIM)
        qb = proj[..., o3:o4].reshape(B, S, N_SB_HEADS, HEAD_DIM)
        kb = proj[..., o4:o5].reshape(B, S, N_SB_HEADS, HEAD_DIM)
        vb = proj[..., o5:].reshape(B, S, N_SB_HEADS, HEAD_DIM)

        ya = swa_sink_attention(qa, ka, va, swa_sinks[l])
        yb = stick_breaking_attention(qb, kb, vb)

        y = jnp.concatenate([rmsnorm(ya, swa_out_norm[l]), rmsnorm(yb, sb_out_norm[l])], axis=-1)
        x = x + y @ w_out[l]

        x = x + 0.5 * swiglu(rmsnorm(x, ffn2_norm[l]), ffn2_w_gate[l], ffn2_w_up[l], ffn2_w_down[l])
    return rmsnorm(x, final_norm)
```

```cpp
#include <hip/hip_runtime.h>
#include <hip/hip_cooperative_groups.h>
#include <cstdio>
#include <cstdint>
#include <type_traits>
namespace cg = cooperative_groups;
namespace pg8 {
#define PG8_LAS __attribute__((address_space(3)))
typedef unsigned short bf16_t;
typedef short bf16x8 __attribute__((ext_vector_type(8)));
typedef float f32x4 __attribute__((ext_vector_type(4)));
typedef unsigned u32x4 __attribute__((ext_vector_type(4)));
typedef int i32x4 __attribute__((ext_vector_type(4)));
typedef int i32x8 __attribute__((ext_vector_type(8)));
constexpr int BM = 256, BK = 64, HALF = 128, HTB = HALF * BK * 2  , STAGE_BYTES = 8 * HTB, NXCD = 8, WGM = 8;

__host__ __device__ __forceinline__ int lds_byte(int r, int c) { const int st = (r >> 4) * 2 + (c >> 5), rr = r & 15, cc = c & 31, ob = rr * 64 + cc * 2; return st * 1024 + (ob ^ (((ob >> 9) & 1) << 5)); }
__host__ __device__ __forceinline__ void stage_rc(int b, int& R, int& C) { const int st = b / 1024, sb = b % 1024, swz = sb ^ (((sb >> 9) & 1) << 5); R = (st >> 1) * 16 + swz / 64; C = (st & 1) * 32 + (swz % 64) / 2; }
__host__ __device__ __forceinline__ int perm32(int rho) { const int n = rho >> 4, i = rho & 15; return 8 * (i >> 2) + 4 * n + (i & 3); }

struct Unit { int pm, pn, ty; };
__host__ __device__ __forceinline__ int invperm32(int s) { return 16 * ((s >> 2) & 1) + 4 * (s >> 3) + (s & 3); }
struct Gemm { const bf16_t* A; const bf16_t* Bt; int M, N, K, ld, blk; };

struct StaticOrder {
    int nM, nN, nwg, G, c, rev;
    __host__ __device__ void init(int M, int N, int G_, int c_, int rev_ = 0) { nM = M / BM; nN = N / BM; nwg = nM * nN; G = G_; c = c_; rev = rev_; }
    __host__ __device__ bool next(int i, Unit& u) const {
        const long L = (long)i * G + c; if (L >= nwg) return false;
        u.ty = 0; map((int)L, u); return true;
    }
    __host__ __device__ void map(int L, Unit& u) const {
        int wgid = L; { const int q = nwg / NXCD, r = nwg % NXCD, xcd = wgid % NXCD, off = wgid / NXCD; wgid = (xcd < r ? xcd * (q + 1) : r * (q + 1) + (xcd - r) * q) + off; }
        const int nig = WGM * nN, gid = wgid / nig, fm = gid * WGM, gsz = (nM - fm) < WGM ? (nM - fm) : WGM;
        u.pm = fm + ((wgid % nig) % gsz); u.pn = (wgid % nig) / gsz; if (rev) u.pm = nM - 1 - u.pm;
    }
    __device__ __forceinline__ const char* pa(const Gemm& g, const Unit& u, size_t tstep) const { return (const char*)g.A + (size_t)u.pm * tstep; }
    __device__ __forceinline__ const char* pb(const Gemm& g, const Unit& u, size_t tstep) const { return (const char*)g.Bt + (size_t)u.pn * tstep; }
    __device__ __forceinline__ void a_ready(const Unit&) const {}
    __device__ __forceinline__ void done(const Unit&) const {}
};

__device__ __forceinline__ unsigned cvt_pk_bf16(float lo, float hi) { unsigned r; asm volatile("v_cvt_pk_bf16_f32 %0, %1, %2" : "=v"(r) : "v"(lo), "v"(hi)); return r; }
typedef float f32x2 __attribute__((ext_vector_type(2)));
typedef unsigned u32x2 __attribute__((ext_vector_type(2)));
typedef float f32x2 __attribute__((ext_vector_type(2)));
__device__ __forceinline__ unsigned pk4_fp8(float a, float b, float c, float d) {
    a = fminf(fmaxf(a, -448.f), 448.f); b = fminf(fmaxf(b, -448.f), 448.f); c = fminf(fmaxf(c, -448.f), 448.f); d = fminf(fmaxf(d, -448.f), 448.f);
    unsigned w = 0; w = __builtin_amdgcn_cvt_pk_fp8_f32(a, b, w, false); w = __builtin_amdgcn_cvt_pk_fp8_f32(c, d, w, true); return w; }
__device__ __forceinline__ float silu_mul(float g, float u) { return g * __builtin_amdgcn_rcpf(1.0f + __builtin_amdgcn_exp2f(-1.4426950408889634f * g)) * u; }

struct EpiSwiglu {
    static constexpr bool PERM = true, AFTER_DRAIN = false, MIDHOOK = false;
    bf16_t* O; int ldc; const float* ssq; float oscale; int nt_blk;
    __device__ __forceinline__ void operator()(const f32x4 (&acc)[2][2][4][2], const Unit& u, int wr, int wc, int fr, int fq) const {
        const int row0 = u.pm * BM + wr * 64 + fr, col0 = u.pn * HALF + wc * 32 + 8 * fq;
#pragma unroll
        for (int ai = 0; ai < 2; ++ai)
#pragma unroll
            for (int m = 0; m < 4; ++m) {
                bf16_t* rowp = nt_blk ? O + (((size_t)u.pm * nt_blk + (col0 >> 6)) * 2 + ai) * (HALF * BK) + (lds_byte(wr * 64 + fr + m * 16, col0 & 63) >> 1)
                                      : O + (size_t)(row0 + ai * HALF + m * 16) * ldc + col0;
                const float rs = (ssq ? rsqrtf(ssq[row0 + ai * HALF + m * 16] * (1.f / 2048.f) + 1e-6f) : 1.f) * oscale;
                const float nrl = -1.4426950408889634f * rs, rs2 = rs * rs;
                u32x4 w;
#pragma unroll
                for (int n = 0; n < 2; ++n)
#pragma unroll
                    for (int hh = 0; hh < 2; ++hh) {
                        const f32x2 g = {acc[ai][0][m][n][2 * hh], acc[ai][0][m][n][2 * hh + 1]}, uu = {acc[ai][1][m][n][2 * hh], acc[ai][1][m][n][2 * hh + 1]};
                        const f32x2 t = g * nrl; f32x2 ex; ex.x = __builtin_amdgcn_exp2f(t.x); ex.y = __builtin_amdgcn_exp2f(t.y);
                        const f32x2 d = ex + 1.0f; f32x2 r; r.x = __builtin_amdgcn_rcpf(d.x); r.y = __builtin_amdgcn_rcpf(d.y);
                        const f32x2 o = (g * uu) * (r * rs2);
                        w[2 * n + hh] = cvt_pk_bf16(o.x, o.y);
                    }
                __builtin_nontemporal_store(w, (u32x4*)rowp);
            }
    }
};
struct EpiResid {
    static constexpr bool PERM = false, AFTER_DRAIN = false, MIDHOOK = false;
    const float* base; float* out; float scale;
    __device__ __forceinline__ void operator()(const f32x4 (&acc)[2][2][4][2], const Unit& u, int wr, int wc, int fr, int fq) const {
        const int col0 = u.pn * BM + wc * 32 + 4 * fq;
#pragma unroll
        for (int ai = 0; ai < 2; ++ai)
#pragma unroll
            for (int m = 0; m < 4; ++m) { const size_t off = (size_t)(u.pm * BM + ai * HALF + wr * 64 + m * 16 + fr) * 2048 + col0;
#pragma unroll
                for (int bj = 0; bj < 2; ++bj)
#pragma unroll
                    for (int n = 0; n < 2; ++n) { const f32x4 bs = *(const f32x4*)(base + off + bj * HALF + n * 16); *(f32x4*)(out + off + bj * HALF + n * 16) = bs + acc[ai][bj][m][n] * scale; } }
    }
};
struct EpiQK {
    static constexpr bool PERM = true, AFTER_DRAIN = false, MIDHOOK = false;
    bf16_t* Q; bf16_t* KF; float qscale; const float* ssq;
    __device__ __forceinline__ void operator()(const f32x4 (&acc)[2][2][4][2], const Unit& u, int wr, int wc, int fr, int fq) const {
        const int row0 = u.pm * BM + wr * 64 + fr;
        if (u.pn < 8) {
            const int col0 = u.pn * BM + wc * 32 + 8 * fq;
#pragma unroll
            for (int ai = 0; ai < 2; ++ai)
#pragma unroll
                for (int m = 0; m < 4; ++m) { bf16_t* rowp = Q + (size_t)(row0 + ai * HALF + m * 16) * 2048 + col0; const float rs = qscale * rsqrtf(ssq[row0 + ai * HALF + m * 16] * (1.f / 2048.f) + 1e-6f);
#pragma unroll
                    for (int bj = 0; bj < 2; ++bj) { const f32x4 v0 = acc[ai][bj][m][0] * rs, v1 = acc[ai][bj][m][1] * rs;
                        u32x4 w; w.x = cvt_pk_bf16(v0[0], v0[1]); w.y = cvt_pk_bf16(v0[2], v0[3]); w.z = cvt_pk_bf16(v1[0], v1[1]); w.w = cvt_pk_bf16(v1[2], v1[3]);
                        *(u32x4*)(rowp + bj * HALF) = w; } }
        } else {
#pragma unroll
            for (int bj = 0; bj < 2; ++bj) {
                const int kcol = (u.pn - 8) * BM + bj * HALF + wc * 32 + 8 * fq, kh = kcol >> 6, chunk = (kcol & 63) >> 3;
#pragma unroll
                for (int ai = 0; ai < 2; ++ai)
#pragma unroll
                    for (int m = 0; m < 4; ++m) { const int r = row0 + ai * HALF + m * 16, b = r >> 11, t = r & 2047;
                        bf16_t* p = KF + (size_t)(b * 20 + kh) * 131072 + (size_t)((t >> 5) * 8 + chunk) * 256 + (t & 31) * 8;
                        const float rs = rsqrtf(ssq[r] * (1.f / 2048.f) + 1e-6f);
                        const f32x4 v0 = acc[ai][bj][m][0] * rs, v1 = acc[ai][bj][m][1] * rs;
                        u32x4 w; w.x = cvt_pk_bf16(v0[0], v0[1]); w.y = cvt_pk_bf16(v0[2], v0[3]); w.z = cvt_pk_bf16(v1[0], v1[1]); w.w = cvt_pk_bf16(v1[2], v1[3]);
                        *(u32x4*)p = w; }
            }
        }
    }
};
struct EpiVT {
    static constexpr bool PERM = true, AFTER_DRAIN = false, MIDHOOK = false;
    bf16_t* VF; const float* ssq;
    __device__ __forceinline__ void operator()(const f32x4 (&acc)[2][2][4][2], const Unit& u, int wr, int wc, int fr, int fq) const {
#pragma unroll
        for (int bj = 0; bj < 2; ++bj) {
            const int tok = u.pn * BM + bj * HALF + wc * 32 + 8 * fq, b = tok >> 11, t = tok & 2047, g = t >> 4, ih = (t & 15) >> 3;
            f32x4 rs0 = *(const f32x4*)(ssq + tok), rs1 = *(const f32x4*)(ssq + tok + 4);
#pragma unroll
            for (int e_ = 0; e_ < 4; ++e_) { rs0[e_] = rsqrtf(rs0[e_] * (1.f / 2048.f) + 1e-6f); rs1[e_] = rsqrtf(rs1[e_] * (1.f / 2048.f) + 1e-6f); }
#pragma unroll
            for (int ai = 0; ai < 2; ++ai)
#pragma unroll
                for (int m = 0; m < 4; ++m) { const int r = u.pm * BM + ai * HALF + wr * 64 + m * 16 + fr, vh = r >> 6, d = r & 63, d0 = d >> 5, dl = d & 31;
                    bf16_t* p = VF + (size_t)(b * 20 + vh) * 131072 + (size_t)((g * 2 + d0) * 2) * 256 + dl * 8 + ih * 4;
                    const f32x4 v0 = acc[ai][bj][m][0] * rs0, v1 = acc[ai][bj][m][1] * rs1;
                    u32x2 w0, w1; w0.x = cvt_pk_bf16(v0[0], v0[1]); w0.y = cvt_pk_bf16(v0[2], v0[3]); w1.x = cvt_pk_bf16(v1[0], v1[1]); w1.y = cvt_pk_bf16(v1[2], v1[3]);
                    *(u32x2*)p = w0;
                    *(u32x2*)(p + 256) = w1; }
        }
    }
};

struct InProjOrder {
    StaticOrder qk, vt; int nqk, ntot, G, c; const bf16_t* X; const bf16_t* Wqk; const bf16_t* Wv;
    __device__ void init(int M, int NQK_, int NVT_, int G_, int c_, const bf16_t* X_, const bf16_t* W_, int K) {
        qk.init(M, NQK_, G_, c_); vt.init(NVT_, M, G_, c_); nqk = qk.nwg; ntot = qk.nwg + vt.nwg; G = G_; c = c_; X = X_; Wqk = W_; Wv = W_ + (size_t)NQK_ * K; }
    __device__ bool next(int i, Unit& u) const { const long L = (long)i * G + c; if (L >= ntot) return false;
        if (L < nqk) { u.ty = 0; qk.map((int)L, u); } else { u.ty = 1; vt.map((int)L - nqk, u); } return true; }
    __device__ __forceinline__ const char* pa(const Gemm&, const Unit& u, size_t tstep) const { return (const char*)(u.ty ? Wv : X) + (size_t)u.pm * tstep; }
    __device__ __forceinline__ const char* pb(const Gemm&, const Unit& u, size_t tstep) const { return (const char*)(u.ty ? X : Wqk) + (size_t)u.pn * tstep; }
    __device__ __forceinline__ void a_ready(const Unit&) const {}
    __device__ __forceinline__ void done(const Unit&) const {}
};
struct EpiInProj {
    static constexpr bool PERM = true, AFTER_DRAIN = false, MIDHOOK = false;
    EpiQK qk; EpiVT vt;
    __device__ __forceinline__ void operator()(const f32x4 (&acc)[2][2][4][2], const Unit& u, int wr, int wc, int fr, int fq) const { if (u.ty == 0) qk(acc, u, wr, wc, fr, fq); else vt(acc, u, wr, wc, fr, fq); }
};

template <bool MID, bool BASE16, bool F32OUT, bool W16, bool W8> struct EpiResidStat {
    static constexpr bool PERM = true, AFTER_DRAIN = false, MIDHOOK = MID;
    const void* base; float* out; bf16_t* xb16; unsigned char* xb8; float* ssq; float scale; const float* ssqy;
    __device__ __forceinline__ void mid(f32x4 (&acc)[2][2][4][2], const Unit& u, int wr, int wc, int fr, int fq) const {
#pragma unroll
        for (int ai = 0; ai < 2; ++ai)
#pragma unroll
            for (int m = 0; m < 4; ++m) { const int r = u.pm * BM + ai * HALF + wr * 64 + m * 16 + fr; const f32x2 sy = *(const f32x2*)(ssqy + 2 * r);
                const float ratio = rsqrtf(sy.x * (1.f / 1024.f) + 1e-6f) * sqrtf(sy.y * (1.f / 1024.f) + 1e-6f);
#pragma unroll
                for (int bj = 0; bj < 2; ++bj)
#pragma unroll
                    for (int n = 0; n < 2; ++n) acc[ai][bj][m][n] *= ratio; }
    }
    __device__ __forceinline__ void operator()(const f32x4 (&acc)[2][2][4][2], const Unit& u, int wr, int wc, int fr, int fq) const {
        const int col0 = u.pn * BM + wc * 32 + 8 * fq;
#pragma unroll
        for (int ai = 0; ai < 2; ++ai) {
            u32x4 b16[4][2]; f32x4 b32[4][2][2]; float sy[4];
#pragma unroll
            for (int m = 0; m < 4; ++m) { const int r = u.pm * BM + ai * HALF + wr * 64 + m * 16 + fr; const size_t off = (size_t)r * 2048 + col0;
                if (MID) sy[m] = ssqy[2 * r + 1];
#pragma unroll
                for (int bj = 0; bj < 2; ++bj) { const size_t o = off + bj * HALF;
                    if constexpr (BASE16) b16[m][bj] = *(const u32x4*)((const bf16_t*)base + o);
                    else { b32[m][bj][0] = *(const f32x4*)((const float*)base + o); b32[m][bj][1] = *(const f32x4*)((const float*)base + o + 4); } } }
#pragma unroll
            for (int m = 0; m < 4; ++m) { const int r = u.pm * BM + ai * HALF + wr * 64 + m * 16 + fr; const size_t off = (size_t)r * 2048 + col0;
                float sc = scale; if (MID) sc *= rsqrtf(sy[m] * (1.f / 1024.f) + 1e-6f);
                float s = 0.f;
#pragma unroll
                for (int bj = 0; bj < 2; ++bj) { const size_t o = off + bj * HALF;
                    f32x4 bs0, bs1;
                    if constexpr (BASE16) { const u32x4 bw = b16[m][bj];
                        bs0 = (f32x4){__uint_as_float(bw.x << 16), __uint_as_float(bw.x & 0xffff0000u), __uint_as_float(bw.y << 16), __uint_as_float(bw.y & 0xffff0000u)};
                        bs1 = (f32x4){__uint_as_float(bw.z << 16), __uint_as_float(bw.z & 0xffff0000u), __uint_as_float(bw.w << 16), __uint_as_float(bw.w & 0xffff0000u)}; }
                    else { bs0 = b32[m][bj][0]; bs1 = b32[m][bj][1]; }
                    const f32x4 v0 = bs0 + acc[ai][bj][m][0] * sc, v1 = bs1 + acc[ai][bj][m][1] * sc;
                    if constexpr (F32OUT) { *(f32x4*)(out + o) = v0; *(f32x4*)(out + o + 4) = v1; }
                    s += ((v0[0] * v0[0] + v0[1] * v0[1]) + (v0[2] * v0[2] + v0[3] * v0[3])) + ((v1[0] * v1[0] + v1[1] * v1[1]) + (v1[2] * v1[2] + v1[3] * v1[3]));
                    if constexpr (W16) { u32x4 w; w.x = cvt_pk_bf16(v0[0], v0[1]); w.y = cvt_pk_bf16(v0[2], v0[3]); w.z = cvt_pk_bf16(v1[0], v1[1]); w.w = cvt_pk_bf16(v1[2], v1[3]); *(u32x4*)(xb16 + o) = w; }
                    if constexpr (W8) { u32x2 w; w.x = pk4_fp8(v0[0], v0[1], v0[2], v0[3]); w.y = pk4_fp8(v1[0], v1[1], v1[2], v1[3]); *(u32x2*)(xb8 + o) = w; } }
                s += __shfl_xor(s, 16); s += __shfl_xor(s, 32);
                if (fq == 0) __hip_atomic_fetch_add(ssq + r, s, __ATOMIC_RELAXED, __HIP_MEMORY_SCOPE_AGENT); }
            asm volatile("" ::: "memory");
        }
    }
};
template <bool F> struct Frags { bf16x8 At[4][2], B0[2][2], B1[2][2]; };
template <> struct Frags<true> { i32x8 At[4], B0[2], B1[2]; };
template <class Epi, class Sched, bool ALIGN_EPI = false, bool SP2 = false, bool FP8 = false>
__device__ __forceinline__ void gemm_phase(PG8_LAS unsigned char* lds, const Gemm g, const Sched& S, const Epi& E) {
    int tid_ = threadIdx.x; asm volatile("" : "+v"(tid_));
    const int tid = tid_, wid = __builtin_amdgcn_readfirstlane(tid >> 6), lane = tid & 63, wr = wid >> 2, wc = wid & 3, fr = lane & 15, fq = lane >> 4;
    const int K = g.K, nt = K / BK, LD = g.blk ? BK : g.ld;
    unsigned voffA[2], voffB[2];
#pragma unroll
    for (int i = 0; i < 2; ++i) { int R, C; stage_rc(tid * 16 + i * 8192, R, C); const int Rb = Epi::PERM ? ((R & ~31) + perm32(R & 31)) : R;
        voffA[i] = (unsigned)(R * LD + C) * 2u; voffB[i] = (unsigned)(Rb * LD + C) * 2u;
        if (g.blk == 2) { voffA[i] = (unsigned)(tid * 16 + i * 8192); voffB[i] = voffA[i]; } }
    const size_t kstep = g.blk ? (size_t)BM * BK * 2 : (size_t)(BK * 2);
    const size_t hstep = (size_t)HALF * LD * 2;
    const size_t tstep = g.blk ? (size_t)nt * BM * BK * 2 : 2 * hstep;
    const unsigned ldsw = (unsigned)wid * 1024u;
    const int aoff = lds_byte(wr * 64 + fr, fq * 8), boff = lds_byte(wc * 32 + fr, fq * 8);
#define PG8_SA(b, h) (((b) * 2 + (h)) * HTB)
#define PG8_SB(b, h) ((4 + (b) * 2 + (h)) * HTB)
#define PG8_STAGE(bufoff, gbase, voff) do { _Pragma("unroll") for (int _i = 0; _i < 2; ++_i) \
        __builtin_amdgcn_global_load_lds((const unsigned*)((const char*)(gbase) + (voff)[_i]), (PG8_LAS unsigned*)(lds + (bufoff) + ldsw + _i * 8192), 16, 0, 0); } while (0)
#define PG8_LDA(dst, b, h) do { if constexpr (FP8) { _Pragma("unroll") for (int m = 0; m < 4; ++m) dst[m] = __builtin_shufflevector(*(const PG8_LAS i32x4*)(lds + PG8_SA(b, h) + aoff + m * 2048), *(const PG8_LAS i32x4*)(lds + PG8_SA(b, h) + aoff + m * 2048 + 1024), 0, 1, 2, 3, 4, 5, 6, 7); } \
    else { _Pragma("unroll") for (int m = 0; m < 4; ++m) _Pragma("unroll") for (int k = 0; k < 2; ++k) dst[m][k] = *(const PG8_LAS bf16x8*)(lds + PG8_SA(b, h) + aoff + m * 2048 + k * 1024); } } while (0)
#define PG8_LDB(dst, b, h) do { if constexpr (FP8) { _Pragma("unroll") for (int n = 0; n < 2; ++n) dst[n] = __builtin_shufflevector(*(const PG8_LAS i32x4*)(lds + PG8_SB(b, h) + boff + n * 2048), *(const PG8_LAS i32x4*)(lds + PG8_SB(b, h) + boff + n * 2048 + 1024), 0, 1, 2, 3, 4, 5, 6, 7); } \
    else { _Pragma("unroll") for (int n = 0; n < 2; ++n) _Pragma("unroll") for (int k = 0; k < 2; ++k) dst[n][k] = *(const PG8_LAS bf16x8*)(lds + PG8_SB(b, h) + boff + n * 2048 + k * 1024); } } while (0)
#define PG8_CAT(x) __builtin_shufflevector(__builtin_bit_cast(i32x4, (x)[0]), __builtin_bit_cast(i32x4, (x)[1]), 0, 1, 2, 3, 4, 5, 6, 7)
#define PG8_MMA(ai, bj, At, Bt) do { __builtin_amdgcn_s_setprio(1); if constexpr (FP8) { _Pragma("unroll") for (int m = 0; m < 4; ++m) _Pragma("unroll") for (int n = 0; n < 2; ++n) \
        asm volatile("v_mfma_f32_16x16x128_f8f6f4 %0, %1, %2, %0" : "+v"(acc[ai][bj][m][n]) : "v"(Bt[n]), "v"(At[m])); } else { \
        _Pragma("unroll") for (int m = 0; m < 4; ++m) _Pragma("unroll") for (int n = 0; n < 2; ++n) _Pragma("unroll") for (int k = 0; k < 2; ++k) \
        acc[ai][bj][m][n] = __builtin_amdgcn_mfma_f32_16x16x32_bf16(Bt[n][k], At[m][k], acc[ai][bj][m][n], 0, 0, 0); } __builtin_amdgcn_s_setprio(0); } while (0)
#define PG8_WAIT_V(n) asm volatile("s_waitcnt vmcnt(" #n ")" ::: "memory")
#define PG8_WAIT_L(n) asm volatile("s_waitcnt lgkmcnt(" #n ")" ::: "memory")
#define PG8_BAR __builtin_amdgcn_s_barrier()
#define PG8_SCHED __builtin_amdgcn_sched_barrier(0)
    Unit cur, nxt; int ui = 0;
    if (!S.next(0, cur)) return;
    f32x4 acc[2][2][4][2];
#pragma unroll
    for (int a = 0; a < 2; ++a)
#pragma unroll
        for (int b = 0; b < 2; ++b)
#pragma unroll
            for (int m = 0; m < 4; ++m)
#pragma unroll
                for (int n = 0; n < 2; ++n) acc[a][b][m][n] = (f32x4){0.f, 0.f, 0.f, 0.f};
    Frags<FP8> frg_; auto& At = frg_.At; auto& B0 = frg_.B0; auto& B1 = frg_.B1;
    const char* cA = S.pa(g, cur, tstep); const char* cB = S.pb(g, cur, tstep);
    S.a_ready(cur);
    if constexpr (SP2) {
        PG8_STAGE(PG8_SB(0, 0), cB, voffB); PG8_STAGE(PG8_SB(0, 1), cB + hstep, voffB); PG8_STAGE(PG8_SA(0, 0), cA, voffA); PG8_STAGE(PG8_SA(0, 1), cA + hstep, voffA);
        if (wr == 1) PG8_BAR;
        PG8_WAIT_V(2); PG8_BAR;
        PG8_STAGE(PG8_SB(1, 0), cB + kstep, voffB); PG8_STAGE(PG8_SA(1, 0), cA + kstep, voffA); PG8_STAGE(PG8_SB(1, 1), cB + hstep + kstep, voffB);
        PG8_WAIT_V(6); PG8_BAR;
    } else {
        PG8_STAGE(PG8_SB(0, 0), cB, voffB); PG8_STAGE(PG8_SA(0, 0), cA, voffA); PG8_STAGE(PG8_SB(0, 1), cB + hstep, voffB); PG8_STAGE(PG8_SA(0, 1), cA + hstep, voffA);
        if (wr == 1) PG8_BAR;
        PG8_WAIT_V(4); PG8_BAR;
        PG8_STAGE(PG8_SB(1, 0), cB + kstep, voffB); PG8_STAGE(PG8_SA(1, 0), cA + kstep, voffA); PG8_STAGE(PG8_SB(1, 1), cB + hstep + kstep, voffB);
        PG8_WAIT_V(6); PG8_BAR;
    }
    for (;;) {
        const bool has_next = S.next(ui + 1, nxt);
        const char* nA = has_next ? S.pa(g, nxt, tstep) : cA; const char* nB = has_next ? S.pb(g, nxt, tstep) : cB;
        for (int t = 0; t < nt; t += 2) {
            if constexpr (Epi::MIDHOOK) { if (t == (nt >> 1)) E.mid(acc, cur, wr, wc, fr, fq); }
            const bool last = (t == nt - 2);
            const char* a1 = cA + (size_t)(t + 1) * kstep;
            const char* a2 = last ? nA : cA + (size_t)(t + 2) * kstep; const char* b2 = last ? nB : cB + (size_t)(t + 2) * kstep;
            const char* a3 = a2 + kstep; const char* b3 = b2 + kstep;
            if (last && has_next) S.a_ready(nxt);
            if constexpr (SP2) {
            PG8_LDB(B0, 0, 0); PG8_LDB(B1, 0, 1); PG8_SCHED; PG8_LDA(At, 0, 0); PG8_STAGE(PG8_SA(1, 1), a1 + hstep, voffA);
            PG8_WAIT_V(8); PG8_WAIT_L(0); PG8_BAR; PG8_MMA(0, 0, At, B0); PG8_MMA(0, 1, At, B1); PG8_BAR; PG8_SCHED;
            PG8_LDA(At, 0, 1); PG8_STAGE(PG8_SB(0, 0), b2, voffB); PG8_STAGE(PG8_SB(0, 1), b2 + hstep, voffB); PG8_STAGE(PG8_SA(0, 0), a2, voffA);
            PG8_WAIT_V(8); PG8_WAIT_L(0); PG8_BAR; PG8_MMA(1, 0, At, B0); PG8_MMA(1, 1, At, B1); PG8_BAR; PG8_SCHED;
            PG8_LDB(B0, 1, 0); PG8_LDB(B1, 1, 1); PG8_SCHED; PG8_LDA(At, 1, 0); PG8_STAGE(PG8_SA(0, 1), a2 + hstep, voffA);
            PG8_WAIT_V(8); PG8_WAIT_L(0); PG8_BAR; PG8_MMA(0, 0, At, B0); PG8_MMA(0, 1, At, B1); PG8_BAR; PG8_SCHED;
            PG8_LDA(At, 1, 1); PG8_STAGE(PG8_SB(1, 0), b3, voffB); PG8_STAGE(PG8_SB(1, 1), b3 + hstep, voffB); PG8_STAGE(PG8_SA(1, 0), a3, voffA);
            PG8_WAIT_V(8); PG8_WAIT_L(0); PG8_BAR; PG8_MMA(1, 0, At, B0); PG8_MMA(1, 1, At, B1); PG8_BAR; PG8_SCHED;
            } else {
            PG8_LDB(B0, 0, 0); PG8_SCHED; PG8_LDA(At, 0, 0); PG8_STAGE(PG8_SA(1, 1), a1 + hstep, voffA);
            PG8_WAIT_L(8); PG8_BAR; PG8_WAIT_L(0); PG8_MMA(0, 0, At, B0); PG8_BAR; PG8_SCHED;
            PG8_LDB(B1, 0, 1); PG8_STAGE(PG8_SB(0, 0), b2, voffB);
            PG8_BAR; PG8_WAIT_L(0); PG8_MMA(0, 1, At, B1); PG8_BAR;
            PG8_LDA(At, 0, 1); PG8_STAGE(PG8_SA(0, 0), a2, voffA);
            PG8_BAR; PG8_WAIT_L(0); PG8_MMA(1, 0, At, B0); PG8_BAR; PG8_SCHED;
            PG8_STAGE(PG8_SB(0, 1), b2 + hstep, voffB);
            PG8_WAIT_V(6); PG8_BAR; PG8_MMA(1, 1, At, B1); PG8_BAR;
            PG8_LDB(B0, 1, 0); PG8_SCHED; PG8_LDA(At, 1, 0); PG8_STAGE(PG8_SA(0, 1), a2 + hstep, voffA);
            PG8_WAIT_L(8); PG8_BAR; PG8_WAIT_L(0); PG8_MMA(0, 0, At, B0); PG8_BAR; PG8_SCHED;
            PG8_LDB(B1, 1, 1); PG8_STAGE(PG8_SB(1, 0), b3, voffB);
            PG8_BAR; PG8_WAIT_L(0); PG8_MMA(0, 1, At, B1); PG8_BAR;
            PG8_LDA(At, 1, 1); PG8_STAGE(PG8_SA(1, 0), a3, voffA);
            PG8_BAR; PG8_WAIT_L(0); PG8_MMA(1, 0, At, B0); PG8_BAR; PG8_SCHED;
            PG8_STAGE(PG8_SB(1, 1), b3 + hstep, voffB);
            PG8_WAIT_V(6); PG8_BAR; PG8_MMA(1, 1, At, B1); PG8_BAR;
            }
        }
        if constexpr (FP8) { asm volatile("s_nop 15\n\ts_nop 15" ::: "memory"); }
        if constexpr (ALIGN_EPI) { if (wr == 0) PG8_BAR; }
        if constexpr (!Epi::AFTER_DRAIN) { E(acc, cur, wr, wc, fr, fq); S.done(cur); }
        if (!has_next) break;
#pragma unroll
        for (int a = 0; a < 2; ++a)
#pragma unroll
            for (int b = 0; b < 2; ++b)
#pragma unroll
                for (int m = 0; m < 4; ++m)
#pragma unroll
                    for (int n = 0; n < 2; ++n) acc[a][b][m][n] = (f32x4){0.f, 0.f, 0.f, 0.f};
        cur = nxt; cA = nA; cB = nB; ++ui;
        if constexpr (ALIGN_EPI) { if (wr == 1) PG8_BAR; }
    }
    PG8_WAIT_V(0);
    if constexpr (!ALIGN_EPI) { if (wr == 0) PG8_BAR; }
    PG8_BAR;
    if constexpr (Epi::AFTER_DRAIN) { E.fused(acc, cur, wr, wc, fr, fq, lds, wid, lane); S.done(cur); }
#undef PG8_SA
#undef PG8_SB
#undef PG8_STAGE
#undef PG8_LDA
#undef PG8_LDB
#undef PG8_MMA
#undef PG8_CAT
#undef PG8_WAIT_V
#undef PG8_WAIT_L
#undef PG8_BAR
#undef PG8_SCHED
}
}
#define LAS __attribute__((address_space(3)))
typedef unsigned short bf16_t;
typedef short bf16x8 __attribute__((ext_vector_type(8)));
typedef float f32x2 __attribute__((ext_vector_type(2)));
typedef float f32x4 __attribute__((ext_vector_type(4)));
typedef float f32x16 __attribute__((ext_vector_type(16)));
typedef unsigned u32x2 __attribute__((ext_vector_type(2)));
typedef unsigned u32x4 __attribute__((ext_vector_type(4)));
constexpr int DM = 2048, SEQ = 2048, NBATCH = 16, MTOK = NBATCH * SEQ, DFF = 5504, NKVH = 20;
constexpr int NQK = 3328;
constexpr int NVT = 1280;
constexpr int LDH = 5568;
constexpr float EPS = 1e-6f;
constexpr float LOG2E = 1.4426950408889634f;
constexpr float QSCALE = 0.125f * LOG2E;
constexpr int NWAVES = 8;
constexpr int LDS_STAGE = 131072, LDS_BYTES = LDS_STAGE + 256;
constexpr size_t MiB = 1u << 20;
constexpr size_t WS_WGU1 = 0, WS_WD1 = 43 * MiB, WS_WIN = WS_WD1 + 22 * MiB, WS_WOUT = WS_WIN + 18 * MiB, WS_WGU2 = WS_WOUT + 8 * MiB, WS_WD2 = WS_WGU2 + 43 * MiB;
constexpr size_t WS_HN = 156 * MiB;
constexpr size_t WS_H = 284 * MiB;
constexpr size_t WS_Q = WS_H, WS_KF = WS_H + 128 * MiB, WS_VF = WS_H + 208 * MiB;
constexpr size_t WS_Y = 636 * MiB;
constexpr size_t WS_SSQ = 764 * MiB;
constexpr size_t WS_CTL = 765 * MiB, CTL_BYTES = 16384;
constexpr size_t WS_X2F8 = 768 * MiB;
constexpr size_t WS_X2B = 832 * MiB;
constexpr size_t WS_END = 960 * MiB;
static_assert(WS_H + (size_t)MTOK * LDH * 2 <= WS_Y, "H fits");
static_assert(WS_WD2 + 22 * MiB <= WS_HN && (size_t)2048 * LDH * 2 <= 22 * MiB, "weights fit");

__device__ __forceinline__ unsigned pk2(float lo, float hi) { unsigned r; asm volatile("v_cvt_pk_bf16_f32 %0, %1, %2" : "=v"(r) : "v"(lo), "v"(hi)); return r; }
__device__ __forceinline__ float bf_lo(unsigned w) { return __uint_as_float(w << 16); }
__device__ __forceinline__ float bf_hi(unsigned w) { return __uint_as_float(w & 0xffff0000u); }
__device__ __forceinline__ float wave_sum(float v) {
#pragma unroll
    for (int o = 1; o < 64; o <<= 1) v += __shfl_xor(v, o);
    return v;
}

__device__ __forceinline__ int dest_row0(int type, int n0) {
    if (type == 0) return n0;
    if (type == 1) return (n0 >> 7) * 256;
    if (type == 2) return (n0 >> 7) * 256 + 128;
    if (n0 < 1024) return n0;
    if (n0 < 1280) return 2048 + (n0 - 1024);
    if (n0 < 1536) return 3328 + (n0 - 1280);
    if (n0 < 2560) return 1024 + (n0 - 1536);
    if (n0 < 3584) return 2304 + (n0 - 2560);
    return n0;
}
__device__ __forceinline__ unsigned pk4_fp8w(float a, float b, float c, float d) {
    a = fminf(fmaxf(a, -448.f), 448.f); b = fminf(fmaxf(b, -448.f), 448.f); c = fminf(fmaxf(c, -448.f), 448.f); d = fminf(fmaxf(d, -448.f), 448.f);
    unsigned w = 0; w = __builtin_amdgcn_cvt_pk_fp8_f32(a, b, w, false); w = __builtin_amdgcn_cvt_pk_fp8_f32(c, d, w, true); return w; }
constexpr float W8_SCALE = 256.f;
template <bool FP8 = false> __device__ __forceinline__ void transpose_item(const float* __restrict__ W, int K, int N, bf16_t* __restrict__ WT, int type, int item, int lane, const float* __restrict__ gk = nullptr, const float* __restrict__ gk2 = nullptr, int ldk = 0, int blk_nt = 0) {
    if (ldk == 0) ldk = K;
    const int nkc = K >> 6, nb = item / nkc, kc = item - nb * nkc, n0 = nb * 128, k0 = kc * 64;
    const int drow = dest_row0(type, n0) + 2 * lane;
    const float* src = W + (size_t)k0 * N + n0 + 2 * lane;
    bf16_t* d0 = WT + (size_t)drow * ldk + k0;
    int img_off1 = 0;
    if (blk_nt) {
        const int rl = drow & 255, pos = (rl & ~31) + pg8::invperm32(rl & 31);
        d0 = WT + (((size_t)(drow >> 8) * blk_nt + kc) * 2 + (pos >> 7)) * 8192; ldk = 0;
        img_off1 = pos & 127; }
#pragma unroll 2
    for (int kb = 0; kb < 8; ++kb) {
        f32x2 v[8];
#pragma unroll
        for (int i = 0; i < 8; ++i) v[i] = *(const f32x2*)(src + (size_t)(kb * 8 + i) * N);
        if (gk) {
            const float* gp = (gk2 && k0 >= 1024) ? gk2 + (k0 - 1024) + kb * 8 : gk + k0 + kb * 8;
#pragma unroll
            for (int i = 0; i < 8; ++i) v[i] *= gp[i];
        }
        if constexpr (FP8) {
            u32x2 a, b;
            a.x = pk4_fp8w(v[0].x * W8_SCALE, v[1].x * W8_SCALE, v[2].x * W8_SCALE, v[3].x * W8_SCALE); a.y = pk4_fp8w(v[4].x * W8_SCALE, v[5].x * W8_SCALE, v[6].x * W8_SCALE, v[7].x * W8_SCALE);
            b.x = pk4_fp8w(v[0].y * W8_SCALE, v[1].y * W8_SCALE, v[2].y * W8_SCALE, v[3].y * W8_SCALE); b.y = pk4_fp8w(v[4].y * W8_SCALE, v[5].y * W8_SCALE, v[6].y * W8_SCALE, v[7].y * W8_SCALE);
            unsigned char* d8 = (unsigned char*)WT + (size_t)drow * ldk + k0 + kb * 8;
            *(u32x2*)d8 = a; *(u32x2*)(d8 + ldk) = b;
            continue;
        }
        u32x4 a, b;
        a.x = pk2(v[0].x, v[1].x); a.y = pk2(v[2].x, v[3].x); a.z = pk2(v[4].x, v[5].x); a.w = pk2(v[6].x, v[7].x);
        b.x = pk2(v[0].y, v[1].y); b.y = pk2(v[2].y, v[3].y); b.z = pk2(v[4].y, v[5].y); b.w = pk2(v[6].y, v[7].y);
        if (blk_nt) { *(u32x4*)(d0 + (pg8::lds_byte(img_off1, kb * 8) >> 1)) = a; *(u32x4*)(d0 + (pg8::lds_byte(img_off1 + 1, kb * 8) >> 1)) = b; }
        else { *(u32x4*)(d0 + kb * 8) = a; *(u32x4*)(d0 + ldk + kb * 8) = b; }
    }
}
__device__ __forceinline__ void rms_row_bf16(const float* xrow, const float* __restrict__ g, bf16_t* orow, int lane) {
    const f32x4* xr = (const f32x4*)xrow + lane;
    f32x4 v[8]; float s = 0.f;
#pragma unroll
    for (int j = 0; j < 8; ++j) { v[j] = xr[64 * j]; s += (v[j].x * v[j].x + v[j].y * v[j].y) + (v[j].z * v[j].z + v[j].w * v[j].w); }
    const float rstd = rsqrtf(wave_sum(s) * (1.f / DM) + EPS);
    u32x2* o8 = (u32x2*)orow + lane;
#pragma unroll
    for (int j = 0; j < 8; ++j) { const f32x4 gv = ((const f32x4*)g)[lane + 64 * j]; u32x2 w; w.x = pk2(v[j].x * rstd * gv.x, v[j].y * rstd * gv.y); w.y = pk2(v[j].z * rstd * gv.z, v[j].w * rstd * gv.w); o8[64 * j] = w; }
}
__device__ __forceinline__ void rms_row_f32(float* xrow, const float* __restrict__ g, int lane) {
    f32x4* xr = (f32x4*)xrow + lane;
    f32x4 v[8]; float s = 0.f;
#pragma unroll
    for (int j = 0; j < 8; ++j) { v[j] = xr[64 * j]; s += (v[j].x * v[j].x + v[j].y * v[j].y) + (v[j].z * v[j].z + v[j].w * v[j].w); }
    const float rstd = rsqrtf(wave_sum(s) * (1.f / DM) + EPS);
#pragma unroll
    for (int j = 0; j < 8; ++j) { const f32x4 gv = ((const f32x4*)g)[lane + 64 * j]; xr[64 * j] = v[j] * rstd * gv; }
}
__device__ __forceinline__ void final_row(const bf16_t* xrow, float ssq, const float* __restrict__ g, float* orow, int lane) {
    const float rstd = rsqrtf(ssq * (1.f / DM) + EPS);
#pragma unroll
    for (int j = 0; j < 4; ++j) { const u32x4 w = ((const u32x4*)xrow)[lane + 64 * j]; const float* gp = g + (lane + 64 * j) * 8; const f32x4 g0 = *(const f32x4*)gp, g1 = *(const f32x4*)(gp + 4);
        f32x4 o0, o1; o0.x = bf_lo(w.x) * rstd * g0.x; o0.y = bf_hi(w.x) * rstd * g0.y; o0.z = bf_lo(w.y) * rstd * g0.z; o0.w = bf_hi(w.y) * rstd * g0.w;
        o1.x = bf_lo(w.z) * rstd * g1.x; o1.y = bf_hi(w.z) * rstd * g1.y; o1.z = bf_lo(w.w) * rstd * g1.z; o1.w = bf_hi(w.w) * rstd * g1.w;
        float* op = orow + (lane + 64 * j) * 8; *(f32x4*)op = o0; *(f32x4*)(op + 4) = o1; }
}
__device__ __forceinline__ void group_norm_row(const bf16_t* yrow, const float* __restrict__ ga, const float* __restrict__ gb, bf16_t* orow, int lane) {
    u32x4 w[4]; float sa = 0.f, sb = 0.f;
#pragma unroll
    for (int j = 0; j < 4; ++j) { w[j] = ((const u32x4*)yrow)[lane + 64 * j]; float s = 0.f;
#pragma unroll
        for (int e = 0; e < 4; ++e) { const float a = bf_lo(w[j][e]), b = bf_hi(w[j][e]); s += a * a + b * b; }
        if (j < 2) sa += s; else sb += s; }
    const float ra = rsqrtf(wave_sum(sa) * (1.f / 1024.f) + EPS), rb = rsqrtf(wave_sum(sb) * (1.f / 1024.f) + EPS);
#pragma unroll
    for (int j = 0; j < 4; ++j) { const float* g = (j < 2 ? ga : gb) + (j & 1) * 512 + lane * 8; const float r = j < 2 ? ra : rb;
        const f32x4 g0 = *(const f32x4*)g, g1 = *(const f32x4*)(g + 4); u32x4 o;
        o.x = pk2(bf_lo(w[j].x) * r * g0.x, bf_hi(w[j].x) * r * g0.y); o.y = pk2(bf_lo(w[j].y) * r * g0.z, bf_hi(w[j].y) * r * g0.w);
        o.z = pk2(bf_lo(w[j].z) * r * g1.x, bf_hi(w[j].z) * r * g1.y); o.w = pk2(bf_lo(w[j].w) * r * g1.z, bf_hi(w[j].w) * r * g1.w);
        ((u32x4*)orow)[lane + 64 * j] = o; }
}

__device__ __forceinline__ int crow(int r, int hi) { return (r & 3) + 8 * (r >> 2) + 4 * hi; }
#define MFMA32(a, b, c) __builtin_amdgcn_mfma_f32_32x32x16_bf16((a), (b), (c), 0, 0, 0)
__device__ __forceinline__ void load_k(bf16x8 (&kf)[8], const bf16_t* __restrict__ Kb, int a, int lane) {
#pragma unroll
    for (int blk = 0; blk < 2; ++blk)
#pragma unroll
        for (int d0 = 0; d0 < 4; ++d0) kf[blk * 4 + d0] = *(const bf16x8*)(Kb + (size_t)(2 * a + blk) * 2048 + d0 * 512 + lane * 8);
}
__device__ __forceinline__ void load_v(bf16x8 (&vf)[8], const bf16_t* __restrict__ Vb, int a, int lane) {
#pragma unroll
    for (int g4 = 0; g4 < 4; ++g4)
#pragma unroll
        for (int d0 = 0; d0 < 2; ++d0) vf[g4 * 2 + d0] = *(const bf16x8*)(Vb + (size_t)((4 * a + g4) * 2 + d0) * 512 + lane * 8);
}
__device__ __forceinline__ bf16x8 pack8(const float (&A)[32], int base) {
    u32x4 w; w.x = pk2(A[base], A[base + 1]); w.y = pk2(A[base + 2], A[base + 3]); w.z = pk2(A[base + 4], A[base + 5]); w.w = pk2(A[base + 6], A[base + 7]);
    return __builtin_bit_cast(bf16x8, w);
}
__device__ __forceinline__ void pv_acc(f32x16 (&o)[2], const float (&A)[32], const bf16x8 (&vf)[8]) {
#pragma unroll
    for (int g4 = 0; g4 < 4; ++g4) { const bf16x8 pa = pack8(A, 8 * g4); o[0] = MFMA32(pa, vf[g4 * 2], o[0]); o[1] = MFMA32(pa, vf[g4 * 2 + 1], o[1]); }
}
__device__ __forceinline__ void qk_tile(float (&z)[32], const bf16x8 (&kf)[8], const bf16x8 (&qr)[4]) {
    f32x16 p0 = {}, p1 = {};
#pragma unroll
    for (int d0 = 0; d0 < 4; ++d0) { p0 = MFMA32(kf[d0], qr[d0], p0); p1 = MFMA32(kf[4 + d0], qr[d0], p1); }
#pragma unroll
    for (int r = 0; r < 16; ++r) { z[r] = p0[r]; z[16 + r] = p1[r]; }
}
template <int BLK> __device__ __forceinline__ void sb_block(f32x16 (&o)[2], float& carry, const f32x16& p, const bf16x8 (&vf)[8], int a, bool diag, int qpos, int hi) {
    float u[16], be[16];
#pragma unroll
    for (int i = 0; i < 16; ++i) { const float e = __builtin_amdgcn_exp2f(fminf(p[i], 126.f)); const float uu = __builtin_amdgcn_rcpf(1.0f + e); u[i] = uu; be[i] = e * uu; }
    if (diag) {
#pragma unroll
        for (int i = 0; i < 16; ++i) { const int key = 64 * a + 32 * BLK + crow(i, hi); if (key >= qpos) { u[i] = 1.f; be[i] = 0.f; } }
    }
    float X[16], T[4], oth[4], PS[4], SS[4];
#pragma unroll
    for (int k = 0; k < 4; ++k) { const float x2 = u[4 * k + 3], x1 = x2 * u[4 * k + 2], x0 = x1 * u[4 * k + 1]; X[4 * k + 3] = 1.f; X[4 * k + 2] = x2; X[4 * k + 1] = x1; X[4 * k] = x0; T[k] = x0 * u[4 * k]; }
#pragma unroll
    for (int k = 0; k < 4; ++k) { oth[k] = __shfl_xor(T[k], 32); PS[k] = T[k] * oth[k]; }
    SS[3] = carry;
#pragma unroll
    for (int k = 2; k >= 0; --k) SS[k] = SS[k + 1] * PS[k + 1];
    carry = SS[0] * PS[0];
    float A[16];
#pragma unroll
    for (int k = 0; k < 4; ++k) { const float R = hi ? SS[k] : SS[k] * oth[k];
        A[4 * k + 3] = be[4 * k + 3] * R; A[4 * k + 2] = be[4 * k + 2] * (X[4 * k + 2] * R); A[4 * k + 1] = be[4 * k + 1] * (X[4 * k + 1] * R); A[4 * k] = be[4 * k] * (X[4 * k] * R); }
#pragma unroll
    for (int j = 0; j < 2; ++j) { u32x4 w; w.x = pk2(A[8 * j], A[8 * j + 1]); w.y = pk2(A[8 * j + 2], A[8 * j + 3]); w.z = pk2(A[8 * j + 4], A[8 * j + 5]); w.w = pk2(A[8 * j + 6], A[8 * j + 7]);
        const bf16x8 pa = __builtin_bit_cast(bf16x8, w); o[0] = MFMA32(pa, vf[(2 * BLK + j) * 2], o[0]); o[1] = MFMA32(pa, vf[(2 * BLK + j) * 2 + 1], o[1]); }
}
__device__ __forceinline__ void sb_tile(f32x16 (&o)[2], float& carry, const bf16x8 (&kf)[8], const bf16x8 (&vf)[8], const bf16x8 (&qr)[4], int a, bool diag, int qpos, int hi) {
    f32x16 p0 = {}, p1 = {};
#pragma unroll
    for (int d0 = 0; d0 < 4; ++d0) { p1 = MFMA32(kf[4 + d0], qr[d0], p1); p0 = MFMA32(kf[d0], qr[d0], p0); }
    sb_block<1>(o, carry, p1, vf, a, diag, qpos, hi);
    sb_block<0>(o, carry, p0, vf, a, diag, qpos, hi);
}
__device__ __forceinline__ void store_o(const f32x16 (&o)[2], bf16_t* Yp  , float* ssqp  , LAS unsigned char* stg, int lane) {
    const int dl = lane & 31, hi = lane >> 5;
    LAS bf16_t* st = (LAS bf16_t*)stg;
#pragma unroll
    for (int d0 = 0; d0 < 2; ++d0)
#pragma unroll
        for (int r = 0; r < 16; ++r) { const unsigned w = pk2(o[d0][r], 0.f); st[crow(r, hi) * 64 + d0 * 32 + dl] = (bf16_t)(w & 0xffffu); }
    asm volatile("s_waitcnt lgkmcnt(0)" ::: "memory");
#pragma unroll
    for (int i = 0; i < 4; ++i) { const int row = i * 8 + (lane >> 3), ch = lane & 7; const u32x4 v = *(const LAS u32x4*)(st + row * 64 + ch * 8); *(u32x4*)(Yp + (size_t)row * 2048 + ch * 8) = v;
        float s = 0.f;
#pragma unroll
        for (int e = 0; e < 4; ++e) { const float a = bf_lo(v[e]), b = bf_hi(v[e]); s += a * a + b * b; }
        s += __shfl_xor(s, 1); s += __shfl_xor(s, 2); s += __shfl_xor(s, 4);
        if (ch == 0) __hip_atomic_fetch_add(ssqp + 2 * row, s, __ATOMIC_RELAXED, __HIP_MEMORY_SCOPE_AGENT); }
    asm volatile("s_waitcnt lgkmcnt(0)" ::: "memory");
}
__device__ __forceinline__ void sb_item(int b, int h, int c, const bf16_t* __restrict__ Q, const bf16_t* __restrict__ KF, const bf16_t* __restrict__ VF, bf16_t* Y, float* ssqy, LAS unsigned char* stg, int lane) {
    const int r32 = lane & 31, hi = lane >> 5, q0 = 32 * c, qpos = q0 + r32;
    const bf16_t* Qrow = Q + (size_t)(b * SEQ + qpos) * 2048 + 1024 + h * 64;
    bf16x8 qr[4];
#pragma unroll
    for (int d0 = 0; d0 < 4; ++d0) qr[d0] = *(const bf16x8*)(Qrow + d0 * 16 + hi * 8);
    const bf16_t* Kb = KF + (size_t)(b * NKVH + 4 + h) * 131072; const bf16_t* Vb = VF + (size_t)(b * NKVH + 4 + h) * 131072;
    f32x16 o[2]; o[0] = f32x16{}; o[1] = f32x16{};
    float carry = 1.f;
    bool diag = true;
    bf16x8 kc[8], kn[8], vf[8];
    int a = c >> 1;
    load_k(kc, Kb, a, lane);
#pragma unroll 1
    for (;;) {
        load_v(vf, Vb, a, lane);
        load_k(kn, Kb, a > 0 ? a - 1 : 0, lane);
        sb_tile(o, carry, kc, vf, qr, a, diag, qpos, hi); diag = false;
        if (a == 0) break;
        if (__all(carry < 1.17549435e-38f)) break;
        --a;
#pragma unroll
        for (int i = 0; i < 8; ++i) kc[i] = kn[i];
    }
    store_o(o, Y + (size_t)(b * SEQ + q0) * 2048 + 1024 + h * 64, ssqy + (size_t)(b * SEQ + q0) * 2 + 1, stg, lane);
}
__device__ __forceinline__ void swa_item(int b, int h, int c, const bf16_t* __restrict__ Q, const bf16_t* __restrict__ KF, const bf16_t* __restrict__ VF, bf16_t* Y, float* ssqy, float sink2, float slope2, LAS unsigned char* stg, int lane) {
    const int r32 = lane & 31, hi = lane >> 5, q0 = 32 * c, qpos = q0 + r32, kv = h >> 2;
    const bf16_t* Qrow = Q + (size_t)(b * SEQ + qpos) * 2048 + h * 64;
    bf16x8 qr[4];
#pragma unroll
    for (int d0 = 0; d0 < 4; ++d0) qr[d0] = *(const bf16x8*)(Qrow + d0 * 16 + hi * 8);
    const bf16_t* Kb = KF + (size_t)(b * NKVH + kv) * 131072; const bf16_t* Vb = VF + (size_t)(b * NKVH + kv) * 131072;
    f32x16 o[2]; o[0] = f32x16{}; o[1] = f32x16{};
    float m = sink2, l = hi ? 0.f : 1.f;
    const int ah = c >> 1;
    bf16x8 kc[8], kn[8], vf[8];
    int a = (ah >= 2 ? ah - 2 : 0);
    load_k(kc, Kb, a, lane);
#pragma unroll 1
    for (;;) {
        load_v(vf, Vb, a, lane);
        load_k(kn, Kb, a < ah ? a + 1 : ah, lane);
        float z[32]; qk_tile(z, kc, qr);
        const float dbase = (float)(qpos - 64 * a - 4 * hi);
        float rm = -INFINITY;
#pragma unroll
        for (int i = 0; i < 32; ++i) { const float dist = dbase - (float)(32 * (i >> 4) + ((i & 15) & 3) + 8 * ((i & 15) >> 2));
            float s = z[i] - slope2 * dist; s = (dist >= 0.f && dist < 128.f) ? s : -INFINITY; z[i] = s; rm = fmaxf(rm, s); }
        rm = fmaxf(rm, __shfl_xor(rm, 32));
        const float mn = fmaxf(m, rm), f = __builtin_amdgcn_exp2f(m - mn); m = mn;
        float A[32]; float ls = 0.f;
#pragma unroll
        for (int i = 0; i < 32; ++i) { A[i] = __builtin_amdgcn_exp2f(z[i] - mn); ls += A[i]; }
        l = l * f + ls;
#pragma unroll
        for (int r = 0; r < 16; ++r) { const float fr_ = __shfl(f, crow(r, hi)); o[0][r] *= fr_; o[1][r] *= fr_; }
        pv_acc(o, A, vf);
        if (a == ah) break;
        ++a;
#pragma unroll
        for (int i = 0; i < 8; ++i) kc[i] = kn[i];
    }
    l += __shfl_xor(l, 32);
    const float inv = 1.0f / l;
#pragma unroll
    for (int r = 0; r < 16; ++r) { const float ir = __shfl(inv, crow(r, hi)); o[0][r] *= ir; o[1][r] *= ir; }
    store_o(o, Y + (size_t)(b * SEQ + q0) * 2048 + h * 64, ssqy + (size_t)(b * SEQ + q0) * 2, stg, lane);
}

#define XB_TMO      128
#define XB_XCNT(j)  (256  + 64 * (j))
#define XB_XSUB(j)  (1280 + 64 * (j))
#define XB_XGEN(j)  (2304 + 64 * (j))
#define XB_TOP      3328
#define XB_TOPGEN   3392
#define XCD_BAR_WORDS 3456
#define XB_SPIN_CAP (1u << 18)

__device__ __forceinline__ unsigned xb_ld(unsigned* p)              { return __hip_atomic_load(p, __ATOMIC_RELAXED, __HIP_MEMORY_SCOPE_AGENT); }
__device__ __forceinline__ unsigned xb_add(unsigned* p, unsigned v) { return __hip_atomic_fetch_add(p, v, __ATOMIC_RELAXED, __HIP_MEMORY_SCOPE_AGENT); }
__device__ __forceinline__ unsigned xb_xcc_id() { return (unsigned)__builtin_amdgcn_s_getreg((3 << 11) | 20) & 0xFu; }
#define XB_SPIN(cond, bar) do { unsigned _sp = 0; while (cond) { __builtin_amdgcn_s_sleep(1); \
    if ((++_sp & 255u) == 0u) { if (xb_ld(&(bar)[XB_TMO])) break; if (_sp > XB_SPIN_CAP) { atomicAdd(&(bar)[XB_TMO], 1u); break; } } } } while (0)

struct XcdBarrier {
    unsigned* bar; unsigned x;
    volatile LAS unsigned* st;
};

__device__ __forceinline__ XcdBarrier xcd_barrier_post(unsigned* bar, volatile LAS unsigned* st) {
    XcdBarrier b; b.bar = bar; b.x = xb_xcc_id(); b.st = st;
    if (threadIdx.x == 0) (void)xb_add(&bar[XB_XCNT(b.x)], 1u);
    return b;
}
__device__ __forceinline__ void xcd_barrier_complete(unsigned* bar, unsigned x, unsigned& nloc, unsigned& nx) {
    const unsigned G = gridDim.x * gridDim.y * gridDim.z;
    unsigned sum, cnt, mine, sp = 0u;
    for (;;) {
        sum = 0u; cnt = 0u; mine = 0u;
#pragma unroll
        for (unsigned j = 0; j < 16; ++j) { const unsigned c = xb_ld(&bar[XB_XCNT(j)]); sum += c; cnt += (c > 0u) ? 1u : 0u; mine = (j == x) ? c : mine; }
        if (sum == G) break;
        __builtin_amdgcn_s_sleep(1);
        if ((++sp & 255u) == 0u) { if (xb_ld(&bar[XB_TMO])) break; if (sp > XB_SPIN_CAP) { atomicAdd(&bar[XB_TMO], 1u); break; } }
    }
    nloc = mine > 0u ? mine : 1u; nx = cnt > 0u ? cnt : 1u;
}

__device__ __forceinline__ void xcd_barrier(const XcdBarrier& b) {
    asm volatile("s_waitcnt vmcnt(0)" ::: "memory");
    __syncthreads();
    if (threadIdx.x == 0) {
        unsigned* bar = b.bar;
        __builtin_amdgcn_s_waitcnt(0);
        unsigned nloc = b.st[0], nx = b.st[1];
        if (nloc == 0u) { xcd_barrier_complete(bar, b.x, nloc, nx); b.st[0] = nloc; b.st[1] = nx; }
        const unsigned old = xb_add(&bar[XB_XSUB(b.x)], 1u);
        const unsigned gen = old / nloc;
        if (old + 1u == (gen + 1u) * nloc) {
            __builtin_amdgcn_fence(__ATOMIC_RELEASE, "agent");
            asm volatile("s_waitcnt vmcnt(0)" ::: "memory");
            const unsigned og = xb_add(&bar[XB_TOP], 1u);
            const unsigned tg = og / nx;
            if (og + 1u == (tg + 1u) * nx) xb_add(&bar[XB_TOPGEN], 1u);
            else XB_SPIN(xb_ld(&bar[XB_TOPGEN]) == tg, bar);
            __builtin_amdgcn_fence(__ATOMIC_ACQUIRE, "agent");
            xb_add(&bar[XB_XGEN(b.x)], 1u);
            asm volatile("s_waitcnt vmcnt(0)" ::: "memory");
        } else {
            XB_SPIN(xb_ld(&bar[XB_XGEN(b.x)]) == gen, bar);
            __builtin_amdgcn_fence(__ATOMIC_ACQUIRE, "agent");
            asm volatile("s_waitcnt vmcnt(0)" ::: "memory");
        }
    }
    __syncthreads();
}

struct Args { const float* in[16]; float* out; unsigned char* ws; };
__global__ void __launch_bounds__(NWAVES * 64, 2) hybrid_fwd(Args args) {
    extern __shared__ __attribute__((aligned(16))) unsigned char lds_raw[];
    LAS unsigned char* lds = (LAS unsigned char*)lds_raw;
    cg::grid_group grid = cg::this_grid();
    volatile LAS unsigned* bst = (volatile LAS unsigned*)(lds + LDS_STAGE);
    if (threadIdx.x < 2) bst[threadIdx.x] = 0u;
    __syncthreads();
    const XcdBarrier xbar = xcd_barrier_post((unsigned*)(args.ws + WS_CTL), bst);
    const int tid = threadIdx.x, lane = tid & 63, wave = __builtin_amdgcn_readfirstlane(tid >> 6);
    const int G = gridDim.x, gw = blockIdx.x * NWAVES + wave, NGW = G * NWAVES;
    unsigned char* ws = args.ws;
    const float* x = args.in[0];
    float* out = args.out;
    bf16_t* WGU1 = (bf16_t*)(ws + WS_WGU1); bf16_t* WD1 = (bf16_t*)(ws + WS_WD1); bf16_t* WIN = (bf16_t*)(ws + WS_WIN); bf16_t* WOUT = (bf16_t*)(ws + WS_WOUT);
    bf16_t* WGU2 = (bf16_t*)(ws + WS_WGU2); bf16_t* WD2 = (bf16_t*)(ws + WS_WD2);
    bf16_t* HN = (bf16_t*)(ws + WS_HN); bf16_t* HB = (bf16_t*)(ws + WS_H); bf16_t* QB = (bf16_t*)(ws + WS_Q); bf16_t* KF = (bf16_t*)(ws + WS_KF); bf16_t* VF = (bf16_t*)(ws + WS_VF);
    bf16_t* YB = (bf16_t*)(ws + WS_Y);
    float* ssq1 = (float*)(ws + WS_SSQ); float* ssq2 = ssq1 + MTOK; float* ssqy = ssq2 + MTOK; float* ssq3 = ssqy + 2 * MTOK;
    unsigned char* X2F8 = ws + WS_X2F8; bf16_t* X2B = (bf16_t*)(ws + WS_X2B);

    {
        constexpr int I_GU = 43 * 32, I_DN = 16 * 86, I_IN = 36 * 32, I_OUT = 16 * 32;
        constexpr int NITEMS = 4 * I_GU + 2 * I_DN + I_IN + I_OUT;
        for (int it = gw; it < NITEMS; it += NGW) {
            int r = it;
            if (r < I_GU) { transpose_item(args.in[2], DM, DFF, WGU1, 1, r, lane); continue; } r -= I_GU;
            if (r < I_GU) { transpose_item(args.in[3], DM, DFF, WGU1, 2, r, lane); continue; } r -= I_GU;
            if (r < I_DN) { transpose_item(args.in[4], DFF, DM, WD1, 0, r, lane, nullptr, nullptr, 0, DFF / 64); continue; } r -= I_DN;
            if (r < I_IN) { transpose_item(args.in[6], DM, 4608, WIN, 3, r, lane, args.in[5]); continue; } r -= I_IN;
            if (r < I_OUT) { transpose_item(args.in[10], DM, DM, WOUT, 0, r, lane, args.in[8], args.in[9]); continue; } r -= I_OUT;
            if (r < I_GU) { transpose_item<true>(args.in[12], DM, DFF, WGU2, 1, r, lane, args.in[11]); continue; } r -= I_GU;
            if (r < I_GU) { transpose_item<true>(args.in[13], DM, DFF, WGU2, 2, r, lane, args.in[11]); continue; } r -= I_GU;
            transpose_item(args.in[14], DFF, DM, WD2, 0, r, lane, nullptr, nullptr, 0, DFF / 64);
        }
        for (int m = gw; m < MTOK; m += NGW) rms_row_bf16(x + (size_t)m * DM, args.in[1], HN + (size_t)m * DM, lane);
        for (int i = blockIdx.x * (NWAVES * 64) + tid; i < 5 * MTOK; i += G * NWAVES * 64) ssq1[i] = 0.f;
    }
    grid.sync();
    {
        pg8::Gemm g{HN, WGU1, MTOK, 2 * DFF, DM, DM, 0}; pg8::StaticOrder S; S.init(MTOK, 2 * DFF, G, (int)blockIdx.x);
        pg8::EpiSwiglu E{HB, LDH, nullptr, 1.0f, DFF / 64};
        pg8::gemm_phase<pg8::EpiSwiglu, pg8::StaticOrder, true, true>(lds, g, S, E);
    }
    xcd_barrier(xbar);
    {
        pg8::Gemm g{HB, WD1, MTOK, DM, DFF, LDH, 2}; pg8::StaticOrder S; S.init(MTOK, DM, G, (int)blockIdx.x, 1);
        pg8::EpiResidStat<false, false, false, true, false> E{x, nullptr, HN, nullptr, ssq1, 0.5f, nullptr};
        pg8::gemm_phase<pg8::EpiResidStat<false, false, false, true, false>, pg8::StaticOrder, false, true>(lds, g, S, E);
    }
    xcd_barrier(xbar);
    {
        pg8::Gemm g{HN, WIN, MTOK, NQK, DM, DM, 0}; pg8::InProjOrder S; S.init(MTOK, NQK, NVT, G, (int)blockIdx.x, HN, WIN, DM);
        pg8::EpiInProj E{pg8::EpiQK{QB, KF, QSCALE, ssq1}, pg8::EpiVT{VF, ssq1}};
        pg8::gemm_phase<pg8::EpiInProj, pg8::InProjOrder, true, true>(lds, g, S, E);
    }
    xcd_barrier(xbar);
    for (int pi = gw; pi < NBATCH * 16 * 8; pi += NGW) {
        const int bh = pi >> 3, s = pi & 7, b = bh >> 4, h = bh & 15;
#pragma unroll 1
        for (int i = 0; i < 8; ++i) { const int c = 16 * (i >> 1) + ((i & 1) ? 15 - s : s); sb_item(b, h, c, QB, KF, VF, YB, ssqy, lds + wave * 4096, lane); }
        const float sink2 = args.in[7][h] * LOG2E, slope2 = __builtin_amdgcn_exp2f(-0.5f * (float)(h + 1)) * LOG2E;
#pragma unroll 1
        for (int i = 0; i < 8; ++i) { const int c = 16 * (i >> 1) + ((i & 1) ? 15 - s : s); swa_item(b, h, c, QB, KF, VF, YB, ssqy, sink2, slope2, lds + wave * 4096, lane); }
    }
    xcd_barrier(xbar);
    {
        pg8::Gemm g{YB, WOUT, MTOK, DM, DM, DM, 0}; pg8::StaticOrder S; S.init(MTOK, DM, G, (int)blockIdx.x);
        pg8::EpiResidStat<true, true, false, true, true> E{HN, nullptr, X2B, X2F8, ssq2, 1.0f, ssqy};
        pg8::gemm_phase<pg8::EpiResidStat<true, true, false, true, true>, pg8::StaticOrder, false, true>(lds, g, S, E);
    }
    xcd_barrier(xbar);
    {
        pg8::Gemm g{(const bf16_t*)X2F8, WGU2, MTOK, 2 * DFF, DM / 2, DM / 2, 0}; pg8::StaticOrder S; S.init(MTOK, 2 * DFF, G, (int)blockIdx.x);
        pg8::EpiSwiglu E{HB, LDH, ssq2, 1.0f / W8_SCALE, DFF / 64};
        pg8::gemm_phase<pg8::EpiSwiglu, pg8::StaticOrder, true, true, true>(lds, g, S, E);
    }
    xcd_barrier(xbar);
    {
        pg8::Gemm g{HB, WD2, MTOK, DM, DFF, LDH, 2}; pg8::StaticOrder S; S.init(MTOK, DM, G, (int)blockIdx.x, 1);
        pg8::EpiResidStat<false, true, false, true, false> E{X2B, nullptr, HN, nullptr, ssq3, 0.5f, nullptr};
        pg8::gemm_phase<pg8::EpiResidStat<false, true, false, true, false>, pg8::StaticOrder, false, true>(lds, g, S, E);
    }
    xcd_barrier(xbar);
    for (int m = gw; m < MTOK; m += NGW) final_row(HN + (size_t)m * DM, ssq3[m], args.in[15], out + (size_t)m * DM, lane);
}

extern "C" void kernel_launch(void* const* d_in, const int* in_sizes, int n_in, void* d_out, int out_size, void* d_ws, size_t ws_size, hipStream_t stream) {
    static int grid_blocks = 0;
    if (grid_blocks == 0) {
        if (n_in != 16 || in_sizes[0] != MTOK * DM || out_size != MTOK * DM || ws_size < WS_END) {
            fprintf(stderr, "kernel_launch: unexpected shapes (n_in %d in0 %d out %d ws %zu)\n", n_in, n_in > 0 ? in_sizes[0] : -1, out_size, ws_size); grid_blocks = -1; return; }
        int dev = 0, cus = 0, per_cu = 0;
        hipGetDevice(&dev);
        hipDeviceGetAttribute(&cus, hipDeviceAttributeMultiprocessorCount, dev);
        hipFuncSetAttribute((const void*)hybrid_fwd, hipFuncAttributeMaxDynamicSharedMemorySize, LDS_BYTES);
        hipOccupancyMaxActiveBlocksPerMultiprocessor(&per_cu, (const void*)hybrid_fwd, NWAVES * 64, LDS_BYTES);
        if (per_cu < 1) { fprintf(stderr, "kernel_launch: occupancy query says %d blocks/CU\n", per_cu); per_cu = 1; }
        grid_blocks = cus * per_cu;
    }
    if (grid_blocks < 0) return;
    if (hipMemsetAsync((char*)d_ws + WS_CTL, 0, CTL_BYTES, stream) != hipSuccess) { fprintf(stderr, "kernel_launch: hipMemsetAsync failed\n"); return; }
    Args a{};
    for (int i = 0; i < 16; ++i) a.in[i] = (const float*)d_in[i];
    a.out = (float*)d_out; a.ws = (unsigned char*)d_ws;
    void* kargs[] = {&a};
    hipError_t e = hipLaunchCooperativeKernel((const void*)hybrid_fwd, dim3(grid_blocks), dim3(NWAVES * 64), kargs, LDS_BYTES, stream);
    if (e != hipSuccess) fprintf(stderr, "cooperative launch failed: %s (grid %d)\n", hipGetErrorString(e), grid_blocks);
}
```

```cpp
#include <hip/hip_runtime.h>
#include <hip/hip_cooperative_groups.h>
#include <cstdio>
#include <cstdint>
#include <type_traits>
namespace cg = cooperative_groups;
namespace pg8 {
#define PG8_LAS __attribute__((address_space(3)))
typedef unsigned short bf16_t;
typedef short bf16x8 __attribute__((ext_vector_type(8)));
typedef float f32x4 __attribute__((ext_vector_type(4)));
typedef unsigned u32x4 __attribute__((ext_vector_type(4)));
typedef int i32x4 __attribute__((ext_vector_type(4)));
typedef int i32x8 __attribute__((ext_vector_type(8)));
__device__ __forceinline__ int lane_id() { int l; asm volatile("v_mbcnt_lo_u32_b32 %0, -1, 0\n\tv_mbcnt_hi_u32_b32 %0, -1, %0" : "=v"(l)); return l; }
constexpr int BM = 256, BK = 64, HALF = 128, HTB = HALF * BK * 2  , STAGE_BYTES = 8 * HTB, NXCD = 8, WGM = 8;

__host__ __device__ __forceinline__ int lds_byte(int r, int c) { const int st = (r >> 4) * 2 + (c >> 5), rr = r & 15, cc = c & 31, ob = rr * 64 + cc * 2; return st * 1024 + (ob ^ (((ob >> 9) & 1) << 5)); }
__host__ __device__ __forceinline__ void stage_rc(int b, int& R, int& C) { const int st = b / 1024, sb = b % 1024, swz = sb ^ (((sb >> 9) & 1) << 5); R = (st >> 1) * 16 + swz / 64; C = (st & 1) * 32 + (swz % 64) / 2; }
__host__ __device__ __forceinline__ int perm32(int rho) { const int n = rho >> 4, i = rho & 15; return 8 * (i >> 2) + 4 * n + (i & 3); }

struct Unit { int pm, pn, ty; };
__host__ __device__ __forceinline__ int invperm32(int s) { return 16 * ((s >> 2) & 1) + 4 * (s >> 3) + (s & 3); }
struct Gemm { const bf16_t* A; const bf16_t* Bt; int M, N, K, ld, blk; };

struct StaticOrder {
    int nM, nN, nwg, G, c, rev;
    __host__ __device__ void init(int M, int N, int G_, int c_, int rev_ = 0) { nM = M / BM; nN = N / BM; nwg = nM * nN; G = G_; c = c_; rev = rev_; }
    __host__ __device__ bool next(int i, Unit& u) const {
        const long L = (long)i * G + c; if (L >= nwg) return false;
        u.ty = 0; map((int)L, u); return true;
    }
    __host__ __device__ void map(int L, Unit& u) const {
        int wgid = L; { const int q = nwg / NXCD, r = nwg % NXCD, xcd = wgid % NXCD, off = wgid / NXCD; wgid = (xcd < r ? xcd * (q + 1) : r * (q + 1) + (xcd - r) * q) + off; }
        const int nig = WGM * nN, gid = wgid / nig, fm = gid * WGM, gsz = (nM - fm) < WGM ? (nM - fm) : WGM;
        u.pm = fm + ((wgid % nig) % gsz); u.pn = (wgid % nig) / gsz; if (rev) u.pm = nM - 1 - u.pm;
    }
    __device__ __forceinline__ const char* pa(const Gemm& g, const Unit& u, size_t tstep) const { return (const char*)g.A + (size_t)u.pm * tstep; }
    __device__ __forceinline__ const char* pb(const Gemm& g, const Unit& u, size_t tstep) const { return (const char*)g.Bt + (size_t)u.pn * tstep; }
    __device__ __forceinline__ void a_ready(const Unit&) const {}
    __device__ __forceinline__ void done(const Unit&) const {}
};

__device__ __forceinline__ unsigned cvt_pk_bf16(float lo, float hi) { unsigned r; asm volatile("v_cvt_pk_bf16_f32 %0, %1, %2" : "=v"(r) : "v"(lo), "v"(hi)); return r; }
typedef float f32x2 __attribute__((ext_vector_type(2)));
typedef unsigned u32x2 __attribute__((ext_vector_type(2)));
typedef float f32x2 __attribute__((ext_vector_type(2)));
__device__ __forceinline__ unsigned pk4_fp8(float a, float b, float c, float d) {
    a = fminf(fmaxf(a, -448.f), 448.f); b = fminf(fmaxf(b, -448.f), 448.f); c = fminf(fmaxf(c, -448.f), 448.f); d = fminf(fmaxf(d, -448.f), 448.f);
    unsigned w = 0; w = __builtin_amdgcn_cvt_pk_fp8_f32(a, b, w, false); w = __builtin_amdgcn_cvt_pk_fp8_f32(c, d, w, true); return w; }
__device__ __forceinline__ float silu_mul(float g, float u) { return g * __builtin_amdgcn_rcpf(1.0f + __builtin_amdgcn_exp2f(-1.4426950408889634f * g)) * u; }

struct EpiSwiglu {
    static constexpr bool PERM = true, AFTER_DRAIN = false, MIDHOOK = false;
    bf16_t* O; int ldc; const float* ssq; float oscale; int nt_blk;
    __device__ __forceinline__ void operator()(const f32x4 (&acc)[2][2][4][2], const Unit& u, int wr, int wc, int fr, int fq) const {
        const int row0 = u.pm * BM + wr * 64 + fr, col0 = u.pn * HALF + wc * 32 + 8 * fq;
#pragma unroll
        for (int ai = 0; ai < 2; ++ai)
#pragma unroll
            for (int m = 0; m < 4; ++m) {
                bf16_t* rowp = nt_blk ? O + (((size_t)u.pm * nt_blk + (col0 >> 6)) * 2 + ai) * (HALF * BK) + (lds_byte(wr * 64 + fr + m * 16, col0 & 63) >> 1)
                                      : O + (size_t)(row0 + ai * HALF + m * 16) * ldc + col0;
                const float rs = (ssq ? rsqrtf(ssq[row0 + ai * HALF + m * 16] * (1.f / 2048.f) + 1e-6f) : 1.f) * oscale;
                const float nrl = -1.4426950408889634f * rs, rs2 = rs * rs;
                u32x4 w;
#pragma unroll
                for (int n = 0; n < 2; ++n)
#pragma unroll
                    for (int hh = 0; hh < 2; ++hh) {
                        const f32x2 g = {acc[ai][0][m][n][2 * hh], acc[ai][0][m][n][2 * hh + 1]}, uu = {acc[ai][1][m][n][2 * hh], acc[ai][1][m][n][2 * hh + 1]};
                        const f32x2 t = g * nrl; f32x2 ex; ex.x = __builtin_amdgcn_exp2f(t.x); ex.y = __builtin_amdgcn_exp2f(t.y);
                        const f32x2 d = ex + 1.0f; f32x2 r; r.x = __builtin_amdgcn_rcpf(d.x); r.y = __builtin_amdgcn_rcpf(d.y);
                        const f32x2 o = (g * uu) * (r * rs2);
                        w[2 * n + hh] = cvt_pk_bf16(o.x, o.y);
                    }
                __builtin_nontemporal_store(w, (u32x4*)rowp);
            }
    }
};
struct EpiResid {
    static constexpr bool PERM = false, AFTER_DRAIN = false, MIDHOOK = false;
    const float* base; float* out; float scale;
    __device__ __forceinline__ void operator()(const f32x4 (&acc)[2][2][4][2], const Unit& u, int wr, int wc, int fr, int fq) const {
        const int col0 = u.pn * BM + wc * 32 + 4 * fq;
#pragma unroll
        for (int ai = 0; ai < 2; ++ai)
#pragma unroll
            for (int m = 0; m < 4; ++m) { const size_t off = (size_t)(u.pm * BM + ai * HALF + wr * 64 + m * 16 + fr) * 2048 + col0;
#pragma unroll
                for (int bj = 0; bj < 2; ++bj)
#pragma unroll
                    for (int n = 0; n < 2; ++n) { const f32x4 bs = *(const f32x4*)(base + off + bj * HALF + n * 16); *(f32x4*)(out + off + bj * HALF + n * 16) = bs + acc[ai][bj][m][n] * scale; } }
    }
};
struct EpiQK {
    static constexpr bool PERM = true, AFTER_DRAIN = false, MIDHOOK = false;
    bf16_t* Q; bf16_t* KF; float qscale; const float* ssq;
    __device__ __forceinline__ void operator()(const f32x4 (&acc)[2][2][4][2], const Unit& u, int wr, int wc, int fr, int fq) const {
        const int row0 = u.pm * BM + wr * 64 + fr;
        if (u.pn < 8) {
            const int col0 = u.pn * BM + wc * 32 + 8 * fq;
#pragma unroll
            for (int ai = 0; ai < 2; ++ai)
#pragma unroll
                for (int m = 0; m < 4; ++m) { bf16_t* rowp = Q + (size_t)(row0 + ai * HALF + m * 16) * 2048 + col0; const float rs = qscale * rsqrtf(ssq[row0 + ai * HALF + m * 16] * (1.f / 2048.f) + 1e-6f);
#pragma unroll
                    for (int bj = 0; bj < 2; ++bj) { const f32x4 v0 = acc[ai][bj][m][0] * rs, v1 = acc[ai][bj][m][1] * rs;
                        u32x4 w; w.x = cvt_pk_bf16(v0[0], v0[1]); w.y = cvt_pk_bf16(v0[2], v0[3]); w.z = cvt_pk_bf16(v1[0], v1[1]); w.w = cvt_pk_bf16(v1[2], v1[3]);
                        *(u32x4*)(rowp + bj * HALF) = w; } }
        } else {
#pragma unroll
            for (int bj = 0; bj < 2; ++bj) {
                const int kcol = (u.pn - 8) * BM + bj * HALF + wc * 32 + 8 * fq, kh = kcol >> 6, chunk = (kcol & 63) >> 3;
#pragma unroll
                for (int ai = 0; ai < 2; ++ai)
#pragma unroll
                    for (int m = 0; m < 4; ++m) { const int r = row0 + ai * HALF + m * 16, b = r >> 11, t = r & 2047;
                        bf16_t* p = KF + (size_t)(b * 20 + kh) * 131072 + (size_t)((t >> 5) * 8 + chunk) * 256 + (t & 31) * 8;
                        const float rs = rsqrtf(ssq[r] * (1.f / 2048.f) + 1e-6f);
                        const f32x4 v0 = acc[ai][bj][m][0] * rs, v1 = acc[ai][bj][m][1] * rs;
                        u32x4 w; w.x = cvt_pk_bf16(v0[0], v0[1]); w.y = cvt_pk_bf16(v0[2], v0[3]); w.z = cvt_pk_bf16(v1[0], v1[1]); w.w = cvt_pk_bf16(v1[2], v1[3]);
                        *(u32x4*)p = w; }
            }
        }
    }
};
struct EpiVT {
    static constexpr bool PERM = true, AFTER_DRAIN = false, MIDHOOK = false;
    bf16_t* VF; const float* ssq;
    __device__ __forceinline__ void operator()(const f32x4 (&acc)[2][2][4][2], const Unit& u, int wr, int wc, int fr, int fq) const {
#pragma unroll
        for (int bj = 0; bj < 2; ++bj) {
            const int tok = u.pn * BM + bj * HALF + wc * 32 + 8 * fq, b = tok >> 11, t = tok & 2047, g = t >> 4, ih = (t & 15) >> 3;
            f32x4 rs0 = *(const f32x4*)(ssq + tok), rs1 = *(const f32x4*)(ssq + tok + 4);
#pragma unroll
            for (int e_ = 0; e_ < 4; ++e_) { rs0[e_] = rsqrtf(rs0[e_] * (1.f / 2048.f) + 1e-6f); rs1[e_] = rsqrtf(rs1[e_] * (1.f / 2048.f) + 1e-6f); }
#pragma unroll
            for (int ai = 0; ai < 2; ++ai)
#pragma unroll
                for (int m = 0; m < 4; ++m) { const int r = u.pm * BM + ai * HALF + wr * 64 + m * 16 + fr, vh = r >> 6, d = r & 63, d0 = d >> 5, dl = d & 31;
                    bf16_t* p = VF + (size_t)(b * 20 + vh) * 131072 + (size_t)((g * 2 + d0) * 2) * 256 + dl * 8 + ih * 4;
                    const f32x4 v0 = acc[ai][bj][m][0] * rs0, v1 = acc[ai][bj][m][1] * rs1;
                    u32x2 w0, w1; w0.x = cvt_pk_bf16(v0[0], v0[1]); w0.y = cvt_pk_bf16(v0[2], v0[3]); w1.x = cvt_pk_bf16(v1[0], v1[1]); w1.y = cvt_pk_bf16(v1[2], v1[3]);
                    *(u32x2*)p = w0;
                    *(u32x2*)(p + 256) = w1; }
        }
    }
};

struct InProjOrder {
    StaticOrder qk, vt; int nqk, ntot, G, c; const bf16_t* X; const bf16_t* Wqk; const bf16_t* Wv;
    __device__ void init(int M, int NQK_, int NVT_, int G_, int c_, const bf16_t* X_, const bf16_t* W_, int K) {
        qk.init(M, NQK_, G_, c_); vt.init(NVT_, M, G_, c_); nqk = qk.nwg; ntot = qk.nwg + vt.nwg; G = G_; c = c_; X = X_; Wqk = W_; Wv = W_ + (size_t)NQK_ * K; }
    __device__ bool next(int i, Unit& u) const { const long L = (long)i * G + c; if (L >= ntot) return false;
        if (L < nqk) { u.ty = 0; qk.map((int)L, u); } else { u.ty = 1; vt.map((int)L - nqk, u); } return true; }
    __device__ __forceinline__ const char* pa(const Gemm&, const Unit& u, size_t tstep) const { return (const char*)(u.ty ? Wv : X) + (size_t)u.pm * tstep; }
    __device__ __forceinline__ const char* pb(const Gemm&, const Unit& u, size_t tstep) const { return (const char*)(u.ty ? X : Wqk) + (size_t)u.pn * tstep; }
    __device__ __forceinline__ void a_ready(const Unit&) const {}
    __device__ __forceinline__ void done(const Unit&) const {}
};
struct EpiInProj {
    static constexpr bool PERM = true, AFTER_DRAIN = false, MIDHOOK = false;
    EpiQK qk; EpiVT vt;
    __device__ __forceinline__ void operator()(const f32x4 (&acc)[2][2][4][2], const Unit& u, int wr, int wc, int fr, int fq) const { if (u.ty == 0) qk(acc, u, wr, wc, fr, fq); else vt(acc, u, wr, wc, fr, fq); }
};

template <bool MID, bool BASE16, bool F32OUT, bool W16, bool W8> struct EpiResidStat {
    static constexpr bool PERM = true, AFTER_DRAIN = false, MIDHOOK = MID;
    const void* base; float* out; bf16_t* xb16; unsigned char* xb8; float* ssq; float scale; const float* ssqy;
    __device__ __forceinline__ void mid(f32x4 (&acc)[2][2][4][2], const Unit& u, int wr, int wc, int fr, int fq) const {
#pragma unroll
        for (int ai = 0; ai < 2; ++ai)
#pragma unroll
            for (int m = 0; m < 4; ++m) { const int r = u.pm * BM + ai * HALF + wr * 64 + m * 16 + fr; const f32x2 sy = *(const f32x2*)(ssqy + 2 * r);
                const float ratio = rsqrtf(sy.x * (1.f / 1024.f) + 1e-6f) * sqrtf(sy.y * (1.f / 1024.f) + 1e-6f);
#pragma unroll
                for (int bj = 0; bj < 2; ++bj)
#pragma unroll
                    for (int n = 0; n < 2; ++n) acc[ai][bj][m][n] *= ratio; }
    }
    __device__ __forceinline__ void operator()(const f32x4 (&acc)[2][2][4][2], const Unit& u, int wr, int wc, int fr, int fq) const {
        const int col0 = u.pn * BM + wc * 32 + 8 * fq;
#pragma unroll
        for (int ai = 0; ai < 2; ++ai) {
            u32x4 b16[4][2]; f32x4 b32[4][2][2]; float sy[4];
#pragma unroll
            for (int m = 0; m < 4; ++m) { const int r = u.pm * BM + ai * HALF + wr * 64 + m * 16 + fr; const size_t off = (size_t)r * 2048 + col0;
                if (MID) sy[m] = ssqy[2 * r + 1];
#pragma unroll
                for (int bj = 0; bj < 2; ++bj) { const size_t o = off + bj * HALF;
                    if constexpr (BASE16) b16[m][bj] = *(const u32x4*)((const bf16_t*)base + o);
                    else { b32[m][bj][0] = *(const f32x4*)((const float*)base + o); b32[m][bj][1] = *(const f32x4*)((const float*)base + o + 4); } } }
#pragma unroll
            for (int m = 0; m < 4; ++m) { const int r = u.pm * BM + ai * HALF + wr * 64 + m * 16 + fr; const size_t off = (size_t)r * 2048 + col0;
                float sc = scale; if (MID) sc *= rsqrtf(sy[m] * (1.f / 1024.f) + 1e-6f);
                float s = 0.f;
#pragma unroll
                for (int bj = 0; bj < 2; ++bj) { const size_t o = off + bj * HALF;
                    f32x4 bs0, bs1;
                    if constexpr (BASE16) { const u32x4 bw = b16[m][bj];
                        bs0 = (f32x4){__uint_as_float(bw.x << 16), __uint_as_float(bw.x & 0xffff0000u), __uint_as_float(bw.y << 16), __uint_as_float(bw.y & 0xffff0000u)};
                        bs1 = (f32x4){__uint_as_float(bw.z << 16), __uint_as_float(bw.z & 0xffff0000u), __uint_as_float(bw.w << 16), __uint_as_float(bw.w & 0xffff0000u)}; }
                    else { bs0 = b32[m][bj][0]; bs1 = b32[m][bj][1]; }
                    const f32x4 v0 = bs0 + acc[ai][bj][m][0] * sc, v1 = bs1 + acc[ai][bj][m][1] * sc;
                    if constexpr (F32OUT) { *(f32x4*)(out + o) = v0; *(f32x4*)(out + o + 4) = v1; }
                    s += ((v0[0] * v0[0] + v0[1] * v0[1]) + (v0[2] * v0[2] + v0[3] * v0[3])) + ((v1[0] * v1[0] + v1[1] * v1[1]) + (v1[2] * v1[2] + v1[3] * v1[3]));
                    if constexpr (W16) { u32x4 w; w.x = cvt_pk_bf16(v0[0], v0[1]); w.y = cvt_pk_bf16(v0[2], v0[3]); w.z = cvt_pk_bf16(v1[0], v1[1]); w.w = cvt_pk_bf16(v1[2], v1[3]); *(u32x4*)(xb16 + o) = w; }
                    if constexpr (W8) { u32x2 w; w.x = pk4_fp8(v0[0], v0[1], v0[2], v0[3]); w.y = pk4_fp8(v1[0], v1[1], v1[2], v1[3]); *(u32x2*)(xb8 + o) = w; } }
                s += __shfl_xor(s, 16); s += __shfl_xor(s, 32);
                if (fq == 0) __hip_atomic_fetch_add(ssq + r, s, __ATOMIC_RELAXED, __HIP_MEMORY_SCOPE_AGENT); }
            asm volatile("" ::: "memory");
        }
    }
};
template <bool F> struct Frags { bf16x8 At[4][2], B0[2][2], B1[2][2]; };
template <> struct Frags<true> { i32x8 At[4], B0[2], B1[2]; };
template <class Epi, class Sched, bool ALIGN_EPI = false, bool SP2 = false, bool FP8 = false>
__device__ __forceinline__ void gemm_phase(PG8_LAS unsigned char* lds, const Gemm g, const Sched& S, const Epi& E, const int wave_s  ) {
    const int tid_ = wave_s * 64 + lane_id();
    const int tid = tid_, wid = wave_s, lane = tid & 63, wr = wid >> 2, wc = wid & 3, fr = lane & 15, fq = lane >> 4;
    const int K = g.K, nt = K / BK, LD = g.blk ? BK : g.ld;
    unsigned voffA[2], voffB[2];
#pragma unroll
    for (int i = 0; i < 2; ++i) { int R, C; stage_rc(tid * 16 + i * 8192, R, C); const int Rb = Epi::PERM ? ((R & ~31) + perm32(R & 31)) : R;
        voffA[i] = (unsigned)(R * LD + C) * 2u; voffB[i] = (unsigned)(Rb * LD + C) * 2u;
        if (g.blk == 2) { voffA[i] = (unsigned)(tid * 16 + i * 8192); voffB[i] = voffA[i]; } }
    const size_t kstep = g.blk ? (size_t)BM * BK * 2 : (size_t)(BK * 2);
    const size_t hstep = (size_t)HALF * LD * 2;
    const size_t tstep = g.blk ? (size_t)nt * BM * BK * 2 : 2 * hstep;
    const unsigned ldsw = (unsigned)wid * 1024u;
    const int aoff = lds_byte(wr * 64 + fr, fq * 8), boff = lds_byte(wc * 32 + fr, fq * 8);
#define PG8_SA(b, h) (((b) * 2 + (h)) * HTB)
#define PG8_SB(b, h) ((4 + (b) * 2 + (h)) * HTB)
#define PG8_STAGE(bufoff, gbase, voff) do { _Pragma("unroll") for (int _i = 0; _i < 2; ++_i) \
        __builtin_amdgcn_global_load_lds((const unsigned*)((const char*)(gbase) + (voff)[_i]), (PG8_LAS unsigned*)(lds + (bufoff) + ldsw + _i * 8192), 16, 0, 0); } while (0)
#define PG8_LDA(dst, b, h) do { if constexpr (FP8) { _Pragma("unroll") for (int m = 0; m < 4; ++m) dst[m] = __builtin_shufflevector(*(const PG8_LAS i32x4*)(lds + PG8_SA(b, h) + aoff + m * 2048), *(const PG8_LAS i32x4*)(lds + PG8_SA(b, h) + aoff + m * 2048 + 1024), 0, 1, 2, 3, 4, 5, 6, 7); } \
    else { _Pragma("unroll") for (int m = 0; m < 4; ++m) _Pragma("unroll") for (int k = 0; k < 2; ++k) dst[m][k] = *(const PG8_LAS bf16x8*)(lds + PG8_SA(b, h) + aoff + m * 2048 + k * 1024); } } while (0)
#define PG8_LDB(dst, b, h) do { if constexpr (FP8) { _Pragma("unroll") for (int n = 0; n < 2; ++n) dst[n] = __builtin_shufflevector(*(const PG8_LAS i32x4*)(lds + PG8_SB(b, h) + boff + n * 2048), *(const PG8_LAS i32x4*)(lds + PG8_SB(b, h) + boff + n * 2048 + 1024), 0, 1, 2, 3, 4, 5, 6, 7); } \
    else { _Pragma("unroll") for (int n = 0; n < 2; ++n) _Pragma("unroll") for (int k = 0; k < 2; ++k) dst[n][k] = *(const PG8_LAS bf16x8*)(lds + PG8_SB(b, h) + boff + n * 2048 + k * 1024); } } while (0)
#define PG8_CAT(x) __builtin_shufflevector(__builtin_bit_cast(i32x4, (x)[0]), __builtin_bit_cast(i32x4, (x)[1]), 0, 1, 2, 3, 4, 5, 6, 7)
#define PG8_MMA(ai, bj, At, Bt) do { __builtin_amdgcn_s_setprio(1); if constexpr (FP8) { _Pragma("unroll") for (int m = 0; m < 4; ++m) _Pragma("unroll") for (int n = 0; n < 2; ++n) \
        asm volatile("v_mfma_f32_16x16x128_f8f6f4 %0, %1, %2, %0" : "+v"(acc[ai][bj][m][n]) : "v"(Bt[n]), "v"(At[m])); } else { \
        _Pragma("unroll") for (int m = 0; m < 4; ++m) _Pragma("unroll") for (int n = 0; n < 2; ++n) _Pragma("unroll") for (int k = 0; k < 2; ++k) \
        acc[ai][bj][m][n] = __builtin_amdgcn_mfma_f32_16x16x32_bf16(Bt[n][k], At[m][k], acc[ai][bj][m][n], 0, 0, 0); } __builtin_amdgcn_s_setprio(0); } while (0)
#define PG8_WAIT_V(n) asm volatile("s_waitcnt vmcnt(" #n ")" ::: "memory")
#define PG8_WAIT_L(n) asm volatile("s_waitcnt lgkmcnt(" #n ")" ::: "memory")
#define PG8_BAR __builtin_amdgcn_s_barrier()
#define PG8_SCHED __builtin_amdgcn_sched_barrier(0)
    Unit cur, nxt; int ui = 0;
    if (!S.next(0, cur)) return;
    f32x4 acc[2][2][4][2];
#pragma unroll
    for (int a = 0; a < 2; ++a)
#pragma unroll
        for (int b = 0; b < 2; ++b)
#pragma unroll
            for (int m = 0; m < 4; ++m)
#pragma unroll
                for (int n = 0; n < 2; ++n) acc[a][b][m][n] = (f32x4){0.f, 0.f, 0.f, 0.f};
    Frags<FP8> frg_; auto& At = frg_.At; auto& B0 = frg_.B0; auto& B1 = frg_.B1;
    const char* cA = S.pa(g, cur, tstep); const char* cB = S.pb(g, cur, tstep);
    S.a_ready(cur);
    if constexpr (SP2) {
        PG8_STAGE(PG8_SB(0, 0), cB, voffB); PG8_STAGE(PG8_SB(0, 1), cB + hstep, voffB); PG8_STAGE(PG8_SA(0, 0), cA, voffA); PG8_STAGE(PG8_SA(0, 1), cA + hstep, voffA);
        if (wr == 1) PG8_BAR;
        PG8_WAIT_V(2); PG8_BAR;
        PG8_STAGE(PG8_SB(1, 0), cB + kstep, voffB); PG8_STAGE(PG8_SA(1, 0), cA + kstep, voffA); PG8_STAGE(PG8_SB(1, 1), cB + hstep + kstep, voffB);
        PG8_WAIT_V(6); PG8_BAR;
    } else {
        PG8_STAGE(PG8_SB(0, 0), cB, voffB); PG8_STAGE(PG8_SA(0, 0), cA, voffA); PG8_STAGE(PG8_SB(0, 1), cB + hstep, voffB); PG8_STAGE(PG8_SA(0, 1), cA + hstep, voffA);
        if (wr == 1) PG8_BAR;
        PG8_WAIT_V(4); PG8_BAR;
        PG8_STAGE(PG8_SB(1, 0), cB + kstep, voffB); PG8_STAGE(PG8_SA(1, 0), cA + kstep, voffA); PG8_STAGE(PG8_SB(1, 1), cB + hstep + kstep, voffB);
        PG8_WAIT_V(6); PG8_BAR;
    }
    for (;;) {
        const bool has_next = S.next(ui + 1, nxt);
        const char* nA = has_next ? S.pa(g, nxt, tstep) : cA; const char* nB = has_next ? S.pb(g, nxt, tstep) : cB;
        for (int t = 0; t < nt; t += 2) {
            if constexpr (Epi::MIDHOOK) { if (t == (nt >> 1)) E.mid(acc, cur, wr, wc, fr, fq); }
            const bool last = (t == nt - 2);
            const char* a1 = cA + (size_t)(t + 1) * kstep;
            const char* a2 = last ? nA : cA + (size_t)(t + 2) * kstep; const char* b2 = last ? nB : cB + (size_t)(t + 2) * kstep;
            const char* a3 = a2 + kstep; const char* b3 = b2 + kstep;
            if (last && has_next) S.a_ready(nxt);
            if constexpr (SP2) {
            PG8_LDB(B0, 0, 0); PG8_LDB(B1, 0, 1); PG8_SCHED; PG8_LDA(At, 0, 0); PG8_STAGE(PG8_SA(1, 1), a1 + hstep, voffA);
            PG8_WAIT_V(8); PG8_WAIT_L(0); PG8_BAR; PG8_MMA(0, 0, At, B0); PG8_MMA(0, 1, At, B1); PG8_BAR; PG8_SCHED;
            PG8_LDA(At, 0, 1); PG8_STAGE(PG8_SB(0, 0), b2, voffB); PG8_STAGE(PG8_SB(0, 1), b2 + hstep, voffB); PG8_STAGE(PG8_SA(0, 0), a2, voffA);
            PG8_WAIT_V(8); PG8_WAIT_L(0); PG8_BAR; PG8_MMA(1, 0, At, B0); PG8_MMA(1, 1, At, B1); PG8_BAR; PG8_SCHED;
            PG8_LDB(B0, 1, 0); PG8_LDB(B1, 1, 1); PG8_SCHED; PG8_LDA(At, 1, 0); PG8_STAGE(PG8_SA(0, 1), a2 + hstep, voffA);
            PG8_WAIT_V(8); PG8_WAIT_L(0); PG8_BAR; PG8_MMA(0, 0, At, B0); PG8_MMA(0, 1, At, B1); PG8_BAR; PG8_SCHED;
            PG8_LDA(At, 1, 1); PG8_STAGE(PG8_SB(1, 0), b3, voffB); PG8_STAGE(PG8_SB(1, 1), b3 + hstep, voffB); PG8_STAGE(PG8_SA(1, 0), a3, voffA);
            PG8_WAIT_V(8); PG8_WAIT_L(0); PG8_BAR; PG8_MMA(1, 0, At, B0); PG8_MMA(1, 1, At, B1); PG8_BAR; PG8_SCHED;
            } else {
            PG8_LDB(B0, 0, 0); PG8_SCHED; PG8_LDA(At, 0, 0); PG8_STAGE(PG8_SA(1, 1), a1 + hstep, voffA);
            PG8_WAIT_L(8); PG8_BAR; PG8_WAIT_L(0); PG8_MMA(0, 0, At, B0); PG8_BAR; PG8_SCHED;
            PG8_LDB(B1, 0, 1); PG8_STAGE(PG8_SB(0, 0), b2, voffB);
            PG8_BAR; PG8_WAIT_L(0); PG8_MMA(0, 1, At, B1); PG8_BAR;
            PG8_LDA(At, 0, 1); PG8_STAGE(PG8_SA(0, 0), a2, voffA);
            PG8_BAR; PG8_WAIT_L(0); PG8_MMA(1, 0, At, B0); PG8_BAR; PG8_SCHED;
            PG8_STAGE(PG8_SB(0, 1), b2 + hstep, voffB);
            PG8_WAIT_V(6); PG8_BAR; PG8_MMA(1, 1, At, B1); PG8_BAR;
            PG8_LDB(B0, 1, 0); PG8_SCHED; PG8_LDA(At, 1, 0); PG8_STAGE(PG8_SA(0, 1), a2 + hstep, voffA);
            PG8_WAIT_L(8); PG8_BAR; PG8_WAIT_L(0); PG8_MMA(0, 0, At, B0); PG8_BAR; PG8_SCHED;
            PG8_LDB(B1, 1, 1); PG8_STAGE(PG8_SB(1, 0), b3, voffB);
            PG8_BAR; PG8_WAIT_L(0); PG8_MMA(0, 1, At, B1); PG8_BAR;
            PG8_LDA(At, 1, 1); PG8_STAGE(PG8_SA(1, 0), a3, voffA);
            PG8_BAR; PG8_WAIT_L(0); PG8_MMA(1, 0, At, B0); PG8_BAR; PG8_SCHED;
            PG8_STAGE(PG8_SB(1, 1), b3 + hstep, voffB);
            PG8_WAIT_V(6); PG8_BAR; PG8_MMA(1, 1, At, B1); PG8_BAR;
            }
        }
        if constexpr (FP8) { asm volatile("s_nop 15\n\ts_nop 15" ::: "memory"); }
        if constexpr (ALIGN_EPI) { if (wr == 0) PG8_BAR; }
        if constexpr (!Epi::AFTER_DRAIN) { E(acc, cur, wr, wc, fr, fq); S.done(cur); }
        if (!has_next) break;
#pragma unroll
        for (int a = 0; a < 2; ++a)
#pragma unroll
            for (int b = 0; b < 2; ++b)
#pragma unroll
                for (int m = 0; m < 4; ++m)
#pragma unroll
                    for (int n = 0; n < 2; ++n) acc[a][b][m][n] = (f32x4){0.f, 0.f, 0.f, 0.f};
        cur = nxt; cA = nA; cB = nB; ++ui;
        if constexpr (ALIGN_EPI) { if (wr == 1) PG8_BAR; }
    }
    PG8_WAIT_V(0);
    if constexpr (!ALIGN_EPI) { if (wr == 0) PG8_BAR; }
    PG8_BAR;
    if constexpr (Epi::AFTER_DRAIN) { E.fused(acc, cur, wr, wc, fr, fq, lds, wid, lane); S.done(cur); }
#undef PG8_SA
#undef PG8_SB
#undef PG8_STAGE
#undef PG8_LDA
#undef PG8_LDB
#undef PG8_MMA
#undef PG8_CAT
#undef PG8_WAIT_V
#undef PG8_WAIT_L
#undef PG8_BAR
#undef PG8_SCHED
}
}
#define LAS __attribute__((address_space(3)))
typedef unsigned short bf16_t;
typedef short bf16x8 __attribute__((ext_vector_type(8)));
typedef float f32x2 __attribute__((ext_vector_type(2)));
typedef float f32x4 __attribute__((ext_vector_type(4)));
typedef float f32x16 __attribute__((ext_vector_type(16)));
typedef unsigned u32x2 __attribute__((ext_vector_type(2)));
typedef unsigned u32x4 __attribute__((ext_vector_type(4)));
constexpr int DM = 2048, SEQ = 2048, NBATCH = 16, MTOK = NBATCH * SEQ, DFF = 5504, NKVH = 20;
constexpr int NQK = 3328;
constexpr int NVT = 1280;
constexpr int LDH = 5568;
constexpr float EPS = 1e-6f;
constexpr float LOG2E = 1.4426950408889634f;
constexpr float QSCALE = 0.125f * LOG2E;
constexpr int NWAVES = 8;
constexpr int LDS_STAGE = 131072, LDS_BYTES = LDS_STAGE + 256;
constexpr size_t MiB = 1u << 20;
constexpr size_t WS_WGU1 = 0, WS_WD1 = 43 * MiB, WS_WIN = WS_WD1 + 22 * MiB, WS_WOUT = WS_WIN + 18 * MiB, WS_WGU2 = WS_WOUT + 8 * MiB, WS_WD2 = WS_WGU2 + 43 * MiB;
constexpr size_t WS_HN = 156 * MiB;
constexpr size_t WS_H = 284 * MiB;
constexpr size_t WS_Q = WS_H, WS_KF = WS_H + 128 * MiB, WS_VF = WS_H + 208 * MiB;
constexpr size_t WS_Y = 636 * MiB;
constexpr size_t WS_SSQ = 764 * MiB;
constexpr size_t WS_CTL = 765 * MiB, CTL_BYTES = 16384;
constexpr size_t WS_X2F8 = 768 * MiB;
constexpr size_t WS_X2B = 832 * MiB;
constexpr size_t WS_END = 960 * MiB;
static_assert(WS_H + (size_t)MTOK * LDH * 2 <= WS_Y, "H fits");
static_assert(WS_WD2 + 22 * MiB <= WS_HN && (size_t)2048 * LDH * 2 <= 22 * MiB, "weights fit");

__device__ __forceinline__ unsigned pk2(float lo, float hi) { unsigned r; asm volatile("v_cvt_pk_bf16_f32 %0, %1, %2" : "=v"(r) : "v"(lo), "v"(hi)); return r; }
__device__ __forceinline__ float bf_lo(unsigned w) { return __uint_as_float(w << 16); }
__device__ __forceinline__ float bf_hi(unsigned w) { return __uint_as_float(w & 0xffff0000u); }
__device__ __forceinline__ float wave_sum(float v) {
#pragma unroll
    for (int o = 1; o < 64; o <<= 1) v += __shfl_xor(v, o);
    return v;
}

__device__ __forceinline__ int dest_row0(int type, int n0) {
    if (type == 0) return n0;
    if (type == 1) return (n0 >> 7) * 256;
    if (type == 2) return (n0 >> 7) * 256 + 128;
    if (n0 < 1024) return n0;
    if (n0 < 1280) return 2048 + (n0 - 1024);
    if (n0 < 1536) return 3328 + (n0 - 1280);
    if (n0 < 2560) return 1024 + (n0 - 1536);
    if (n0 < 3584) return 2304 + (n0 - 2560);
    return n0;
}
__device__ __forceinline__ unsigned pk4_fp8w(float a, float b, float c, float d) {
    a = fminf(fmaxf(a, -448.f), 448.f); b = fminf(fmaxf(b, -448.f), 448.f); c = fminf(fmaxf(c, -448.f), 448.f); d = fminf(fmaxf(d, -448.f), 448.f);
    unsigned w = 0; w = __builtin_amdgcn_cvt_pk_fp8_f32(a, b, w, false); w = __builtin_amdgcn_cvt_pk_fp8_f32(c, d, w, true); return w; }
constexpr float W8_SCALE = 256.f;
template <bool FP8 = false> __device__ __forceinline__ void transpose_item(const float* __restrict__ W, int K, int N, bf16_t* __restrict__ WT, int type, int item, int lane, const float* __restrict__ gk = nullptr, const float* __restrict__ gk2 = nullptr, int ldk = 0, int blk_nt = 0) {
    if (ldk == 0) ldk = K;
    const int nkc = K >> 6, nb = item / nkc, kc = item - nb * nkc, n0 = nb * 128, k0 = kc * 64;
    const int drow = dest_row0(type, n0) + 2 * lane;
    const float* src = W + (size_t)k0 * N + n0 + 2 * lane;
    bf16_t* d0 = WT + (size_t)drow * ldk + k0;
    int img_off1 = 0;
    if (blk_nt) {
        const int rl = drow & 255, pos = (rl & ~31) + pg8::invperm32(rl & 31);
        d0 = WT + (((size_t)(drow >> 8) * blk_nt + kc) * 2 + (pos >> 7)) * 8192; ldk = 0;
        img_off1 = pos & 127; }
#pragma unroll 2
    for (int kb = 0; kb < 8; ++kb) {
        f32x2 v[8];
#pragma unroll
        for (int i = 0; i < 8; ++i) v[i] = *(const f32x2*)(src + (size_t)(kb * 8 + i) * N);
        if (gk) {
            const float* gp = (gk2 && k0 >= 1024) ? gk2 + (k0 - 1024) + kb * 8 : gk + k0 + kb * 8;
#pragma unroll
            for (int i = 0; i < 8; ++i) v[i] *= gp[i];
        }
        if constexpr (FP8) {
            u32x2 a, b;
            a.x = pk4_fp8w(v[0].x * W8_SCALE, v[1].x * W8_SCALE, v[2].x * W8_SCALE, v[3].x * W8_SCALE); a.y = pk4_fp8w(v[4].x * W8_SCALE, v[5].x * W8_SCALE, v[6].x * W8_SCALE, v[7].x * W8_SCALE);
            b.x = pk4_fp8w(v[0].y * W8_SCALE, v[1].y * W8_SCALE, v[2].y * W8_SCALE, v[3].y * W8_SCALE); b.y = pk4_fp8w(v[4].y * W8_SCALE, v[5].y * W8_SCALE, v[6].y * W8_SCALE, v[7].y * W8_SCALE);
            unsigned char* d8 = (unsigned char*)WT + (size_t)drow * ldk + k0 + kb * 8;
            *(u32x2*)d8 = a; *(u32x2*)(d8 + ldk) = b;
            continue;
        }
        u32x4 a, b;
        a.x = pk2(v[0].x, v[1].x); a.y = pk2(v[2].x, v[3].x); a.z = pk2(v[4].x, v[5].x); a.w = pk2(v[6].x, v[7].x);
        b.x = pk2(v[0].y, v[1].y); b.y = pk2(v[2].y, v[3].y); b.z = pk2(v[4].y, v[5].y); b.w = pk2(v[6].y, v[7].y);
        if (blk_nt) { *(u32x4*)(d0 + (pg8::lds_byte(img_off1, kb * 8) >> 1)) = a; *(u32x4*)(d0 + (pg8::lds_byte(img_off1 + 1, kb * 8) >> 1)) = b; }
        else { *(u32x4*)(d0 + kb * 8) = a; *(u32x4*)(d0 + ldk + kb * 8) = b; }
    }
}
__device__ __forceinline__ void rms_row_bf16(const float* xrow, const float* __restrict__ g, bf16_t* orow, int lane) {
    const f32x4* xr = (const f32x4*)xrow + lane;
    f32x4 v[8]; float s = 0.f;
#pragma unroll
    for (int j = 0; j < 8; ++j) { v[j] = xr[64 * j]; s += (v[j].x * v[j].x + v[j].y * v[j].y) + (v[j].z * v[j].z + v[j].w * v[j].w); }
    const float rstd = rsqrtf(wave_sum(s) * (1.f / DM) + EPS);
    u32x2* o8 = (u32x2*)orow + lane;
#pragma unroll
    for (int j = 0; j < 8; ++j) { const f32x4 gv = ((const f32x4*)g)[lane + 64 * j]; u32x2 w; w.x = pk2(v[j].x * rstd * gv.x, v[j].y * rstd * gv.y); w.y = pk2(v[j].z * rstd * gv.z, v[j].w * rstd * gv.w); o8[64 * j] = w; }
}
__device__ __forceinline__ void rms_row_f32(float* xrow, const float* __restrict__ g, int lane) {
    f32x4* xr = (f32x4*)xrow + lane;
    f32x4 v[8]; float s = 0.f;
#pragma unroll
    for (int j = 0; j < 8; ++j) { v[j] = xr[64 * j]; s += (v[j].x * v[j].x + v[j].y * v[j].y) + (v[j].z * v[j].z + v[j].w * v[j].w); }
    const float rstd = rsqrtf(wave_sum(s) * (1.f / DM) + EPS);
#pragma unroll
    for (int j = 0; j < 8; ++j) { const f32x4 gv = ((const f32x4*)g)[lane + 64 * j]; xr[64 * j] = v[j] * rstd * gv; }
}
__device__ __forceinline__ void final_row(const bf16_t* xrow, float ssq, const float* __restrict__ g, float* orow, int lane) {
    const float rstd = rsqrtf(ssq * (1.f / DM) + EPS);
#pragma unroll
    for (int j = 0; j < 4; ++j) { const u32x4 w = ((const u32x4*)xrow)[lane + 64 * j]; const float* gp = g + (lane + 64 * j) * 8; const f32x4 g0 = *(const f32x4*)gp, g1 = *(const f32x4*)(gp + 4);
        f32x4 o0, o1; o0.x = bf_lo(w.x) * rstd * g0.x; o0.y = bf_hi(w.x) * rstd * g0.y; o0.z = bf_lo(w.y) * rstd * g0.z; o0.w = bf_hi(w.y) * rstd * g0.w;
        o1.x = bf_lo(w.z) * rstd * g1.x; o1.y = bf_hi(w.z) * rstd * g1.y; o1.z = bf_lo(w.w) * rstd * g1.z; o1.w = bf_hi(w.w) * rstd * g1.w;
        float* op = orow + (lane + 64 * j) * 8; *(f32x4*)op = o0; *(f32x4*)(op + 4) = o1; }
}
__device__ __forceinline__ void group_norm_row(const bf16_t* yrow, const float* __restrict__ ga, const float* __restrict__ gb, bf16_t* orow, int lane) {
    u32x4 w[4]; float sa = 0.f, sb = 0.f;
#pragma unroll
    for (int j = 0; j < 4; ++j) { w[j] = ((const u32x4*)yrow)[lane + 64 * j]; float s = 0.f;
#pragma unroll
        for (int e = 0; e < 4; ++e) { const float a = bf_lo(w[j][e]), b = bf_hi(w[j][e]); s += a * a + b * b; }
        if (j < 2) sa += s; else sb += s; }
    const float ra = rsqrtf(wave_sum(sa) * (1.f / 1024.f) + EPS), rb = rsqrtf(wave_sum(sb) * (1.f / 1024.f) + EPS);
#pragma unroll
    for (int j = 0; j < 4; ++j) { const float* g = (j < 2 ? ga : gb) + (j & 1) * 512 + lane * 8; const float r = j < 2 ? ra : rb;
        const f32x4 g0 = *(const f32x4*)g, g1 = *(const f32x4*)(g + 4); u32x4 o;
        o.x = pk2(bf_lo(w[j].x) * r * g0.x, bf_hi(w[j].x) * r * g0.y); o.y = pk2(bf_lo(w[j].y) * r * g0.z, bf_hi(w[j].y) * r * g0.w);
        o.z = pk2(bf_lo(w[j].z) * r * g1.x, bf_hi(w[j].z) * r * g1.y); o.w = pk2(bf_lo(w[j].w) * r * g1.z, bf_hi(w[j].w) * r * g1.w);
        ((u32x4*)orow)[lane + 64 * j] = o; }
}

__device__ __forceinline__ int crow(int r, int hi) { return (r & 3) + 8 * (r >> 2) + 4 * hi; }
#define MFMA32(a, b, c) __builtin_amdgcn_mfma_f32_32x32x16_bf16((a), (b), (c), 0, 0, 0)
__device__ __forceinline__ void load_k(bf16x8 (&kf)[8], const bf16_t* __restrict__ Kb, int a, int lane) {
#pragma unroll
    for (int blk = 0; blk < 2; ++blk)
#pragma unroll
        for (int d0 = 0; d0 < 4; ++d0) kf[blk * 4 + d0] = *(const bf16x8*)(Kb + (size_t)(2 * a + blk) * 2048 + d0 * 512 + lane * 8);
}
__device__ __forceinline__ void load_v(bf16x8 (&vf)[8], const bf16_t* __restrict__ Vb, int a, int lane) {
#pragma unroll
    for (int g4 = 0; g4 < 4; ++g4)
#pragma unroll
        for (int d0 = 0; d0 < 2; ++d0) vf[g4 * 2 + d0] = *(const bf16x8*)(Vb + (size_t)((4 * a + g4) * 2 + d0) * 512 + lane * 8);
}
__device__ __forceinline__ bf16x8 pack8(const float (&A)[32], int base) {
    u32x4 w; w.x = pk2(A[base], A[base + 1]); w.y = pk2(A[base + 2], A[base + 3]); w.z = pk2(A[base + 4], A[base + 5]); w.w = pk2(A[base + 6], A[base + 7]);
    return __builtin_bit_cast(bf16x8, w);
}
__device__ __forceinline__ void pv_acc(f32x16 (&o)[2], const float (&A)[32], const bf16x8 (&vf)[8]) {
#pragma unroll
    for (int g4 = 0; g4 < 4; ++g4) { const bf16x8 pa = pack8(A, 8 * g4); o[0] = MFMA32(pa, vf[g4 * 2], o[0]); o[1] = MFMA32(pa, vf[g4 * 2 + 1], o[1]); }
}
__device__ __forceinline__ void qk_tile(float (&z)[32], const bf16x8 (&kf)[8], const bf16x8 (&qr)[4]) {
    f32x16 p0 = {}, p1 = {};
#pragma unroll
    for (int d0 = 0; d0 < 4; ++d0) { p0 = MFMA32(kf[d0], qr[d0], p0); p1 = MFMA32(kf[4 + d0], qr[d0], p1); }
#pragma unroll
    for (int r = 0; r < 16; ++r) { z[r] = p0[r]; z[16 + r] = p1[r]; }
}
template <int BLK> __device__ __forceinline__ void sb_block(f32x16 (&o)[2], float& carry, const f32x16& p, const bf16x8 (&vf)[8], int a, bool diag, int qpos, int hi) {
    float u[16], be[16];
#pragma unroll
    for (int i = 0; i < 16; ++i) { const float e = __builtin_amdgcn_exp2f(fminf(p[i], 126.f)); const float uu = __builtin_amdgcn_rcpf(1.0f + e); u[i] = uu; be[i] = e * uu; }
    if (diag) {
#pragma unroll
        for (int i = 0; i < 16; ++i) { const int key = 64 * a + 32 * BLK + crow(i, hi); if (key >= qpos) { u[i] = 1.f; be[i] = 0.f; } }
    }
    float X[16], T[4], oth[4], PS[4], SS[4];
#pragma unroll
    for (int k = 0; k < 4; ++k) { const float x2 = u[4 * k + 3], x1 = x2 * u[4 * k + 2], x0 = x1 * u[4 * k + 1]; X[4 * k + 3] = 1.f; X[4 * k + 2] = x2; X[4 * k + 1] = x1; X[4 * k] = x0; T[k] = x0 * u[4 * k]; }
#pragma unroll
    for (int k = 0; k < 4; ++k) { oth[k] = __shfl_xor(T[k], 32); PS[k] = T[k] * oth[k]; }
    SS[3] = carry;
#pragma unroll
    for (int k = 2; k >= 0; --k) SS[k] = SS[k + 1] * PS[k + 1];
    carry = SS[0] * PS[0];
    float A[16];
#pragma unroll
    for (int k = 0; k < 4; ++k) { const float R = hi ? SS[k] : SS[k] * oth[k];
        A[4 * k + 3] = be[4 * k + 3] * R; A[4 * k + 2] = be[4 * k + 2] * (X[4 * k + 2] * R); A[4 * k + 1] = be[4 * k + 1] * (X[4 * k + 1] * R); A[4 * k] = be[4 * k] * (X[4 * k] * R); }
#pragma unroll
    for (int j = 0; j < 2; ++j) { u32x4 w; w.x = pk2(A[8 * j], A[8 * j + 1]); w.y = pk2(A[8 * j + 2], A[8 * j + 3]); w.z = pk2(A[8 * j + 4], A[8 * j + 5]); w.w = pk2(A[8 * j + 6], A[8 * j + 7]);
        const bf16x8 pa = __builtin_bit_cast(bf16x8, w); o[0] = MFMA32(pa, vf[(2 * BLK + j) * 2], o[0]); o[1] = MFMA32(pa, vf[(2 * BLK + j) * 2 + 1], o[1]); }
}
__device__ __forceinline__ void sb_tile(f32x16 (&o)[2], float& carry, const bf16x8 (&kf)[8], const bf16x8 (&vf)[8], const bf16x8 (&qr)[4], int a, bool diag, int qpos, int hi) {
    f32x16 p0 = {}, p1 = {};
#pragma unroll
    for (int d0 = 0; d0 < 4; ++d0) { p1 = MFMA32(kf[4 + d0], qr[d0], p1); p0 = MFMA32(kf[d0], qr[d0], p0); }
    sb_block<1>(o, carry, p1, vf, a, diag, qpos, hi);
    sb_block<0>(o, carry, p0, vf, a, diag, qpos, hi);
}
__device__ __forceinline__ void store_o(const f32x16 (&o)[2], bf16_t* Yp  , float* ssqp  , LAS unsigned char* stg, int lane) {
    const int dl = lane & 31, hi = lane >> 5;
    LAS bf16_t* st = (LAS bf16_t*)stg;
#pragma unroll
    for (int d0 = 0; d0 < 2; ++d0)
#pragma unroll
        for (int r = 0; r < 16; ++r) { const unsigned w = pk2(o[d0][r], 0.f); st[crow(r, hi) * 64 + d0 * 32 + dl] = (bf16_t)(w & 0xffffu); }
    asm volatile("s_waitcnt lgkmcnt(0)" ::: "memory");
#pragma unroll
    for (int i = 0; i < 4; ++i) { const int row = i * 8 + (lane >> 3), ch = lane & 7; const u32x4 v = *(const LAS u32x4*)(st + row * 64 + ch * 8); *(u32x4*)(Yp + (size_t)row * 2048 + ch * 8) = v;
        float s = 0.f;
#pragma unroll
        for (int e = 0; e < 4; ++e) { const float a = bf_lo(v[e]), b = bf_hi(v[e]); s += a * a + b * b; }
        s += __shfl_xor(s, 1); s += __shfl_xor(s, 2); s += __shfl_xor(s, 4);
        if (ch == 0) __hip_atomic_fetch_add(ssqp + 2 * row, s, __ATOMIC_RELAXED, __HIP_MEMORY_SCOPE_AGENT); }
    asm volatile("s_waitcnt lgkmcnt(0)" ::: "memory");
}
__device__ __forceinline__ void load_kb(bf16x8 (&kf)[4], const bf16_t* __restrict__ Kb, int kb, int lane) {
#pragma unroll
    for (int d0 = 0; d0 < 4; ++d0) kf[d0] = *(const bf16x8*)(Kb + (size_t)kb * 2048 + d0 * 512 + lane * 8);
}
__device__ __forceinline__ void load_vb(bf16x8 (&vf)[4], const bf16_t* __restrict__ Vb, int kb, int lane) {
#pragma unroll
    for (int j = 0; j < 2; ++j)
#pragma unroll
        for (int d0 = 0; d0 < 2; ++d0) vf[j * 2 + d0] = *(const bf16x8*)(Vb + (size_t)((2 * kb + j) * 2 + d0) * 512 + lane * 8);
}
__device__ __forceinline__ void pv_block(f32x16 (&o)[2], const f32x16& p, const bf16x8 (&vf)[4]) {
#pragma unroll
    for (int j = 0; j < 2; ++j) { u32x4 w; w.x = pk2(p[8 * j], p[8 * j + 1]); w.y = pk2(p[8 * j + 2], p[8 * j + 3]); w.z = pk2(p[8 * j + 4], p[8 * j + 5]); w.w = pk2(p[8 * j + 6], p[8 * j + 7]);
        const bf16x8 pa = __builtin_bit_cast(bf16x8, w); o[0] = MFMA32(pa, vf[j * 2], o[0]); o[1] = MFMA32(pa, vf[j * 2 + 1], o[1]); }
}
__device__ __forceinline__ void sb_item(int b, int h, int c, const bf16_t* __restrict__ Q, const bf16_t* __restrict__ KF, const bf16_t* __restrict__ VF, bf16_t* Y, float* ssqy, LAS unsigned char* stg, int lane) {
    const int r32 = lane & 31, hi = lane >> 5, q0 = 32 * c, qpos = q0 + r32;
    const bf16_t* Qrow = Q + (size_t)(b * SEQ + qpos) * 2048 + 1024 + h * 64;
    bf16x8 qr[4];
#pragma unroll
    for (int d0 = 0; d0 < 4; ++d0) qr[d0] = *(const bf16x8*)(Qrow + d0 * 16 + hi * 8);
    const bf16_t* Kb = KF + (size_t)(b * NKVH + 4 + h) * 131072; const bf16_t* Vb = VF + (size_t)(b * NKVH + 4 + h) * 131072;
    f32x16 o[2]; o[0] = f32x16{}; o[1] = f32x16{};
    float carry = 1.f;
    bf16x8 kc[4], kn[4], vc[4], vn[4];
    int kb = c;
    load_kb(kc, Kb, kb, lane); load_vb(vc, Vb, kb, lane);
#pragma unroll 1
    for (;;) {
        const int kp = kb > 0 ? kb - 1 : 0;
        load_kb(kn, Kb, kp, lane); load_vb(vn, Vb, kp, lane);
        f32x16 p = {};
#pragma unroll
        for (int d0 = 0; d0 < 4; ++d0) p = MFMA32(kc[d0], qr[d0], p);
        float u[16], be[16];
#pragma unroll
        for (int i = 0; i < 16; ++i) { const float e = __builtin_amdgcn_exp2f(fminf(p[i], 126.f)); const float uu = __builtin_amdgcn_rcpf(1.0f + e); u[i] = uu; be[i] = e * uu; }
        if (kb == c) {
#pragma unroll
            for (int i = 0; i < 16; ++i) { if (crow(i, hi) >= r32) { u[i] = 1.f; be[i] = 0.f; } }
        }
        float X[16], T[4], oth[4], PS[4], SS[4];
#pragma unroll
        for (int k = 0; k < 4; ++k) { const float x2 = u[4 * k + 3], x1 = x2 * u[4 * k + 2], x0 = x1 * u[4 * k + 1]; X[4 * k + 3] = 1.f; X[4 * k + 2] = x2; X[4 * k + 1] = x1; X[4 * k] = x0; T[k] = x0 * u[4 * k]; }
#pragma unroll
        for (int k = 0; k < 4; ++k) { oth[k] = __shfl_xor(T[k], 32); PS[k] = T[k] * oth[k]; }
        SS[3] = carry;
#pragma unroll
        for (int k = 2; k >= 0; --k) SS[k] = SS[k + 1] * PS[k + 1];
        carry = SS[0] * PS[0];
#pragma unroll
        for (int k = 0; k < 4; ++k) { const float R = hi ? SS[k] : SS[k] * oth[k];
            p[4 * k + 3] = be[4 * k + 3] * R; p[4 * k + 2] = be[4 * k + 2] * (X[4 * k + 2] * R); p[4 * k + 1] = be[4 * k + 1] * (X[4 * k + 1] * R); p[4 * k] = be[4 * k] * (X[4 * k] * R); }
        pv_block(o, p, vc);
        if (kb == 0) break;
        if (__all(carry < 1.17549435e-38f)) break;
        --kb;
#pragma unroll
        for (int i = 0; i < 4; ++i) { kc[i] = kn[i]; vc[i] = vn[i]; }
    }
    store_o(o, Y + (size_t)(b * SEQ + q0) * 2048 + 1024 + h * 64, ssqy + (size_t)(b * SEQ + q0) * 2 + 1, stg, lane);
}
__device__ __forceinline__ void swa_item(int b, int h, int c, const bf16_t* __restrict__ Q, const bf16_t* __restrict__ KF, const bf16_t* __restrict__ VF, bf16_t* Y, float* ssqy, float sink2, float slope2, LAS unsigned char* stg, int lane) {
    const int r32 = lane & 31, hi = lane >> 5, q0 = 32 * c, qpos = q0 + r32, kv = h >> 2;
    const bf16_t* Qrow = Q + (size_t)(b * SEQ + qpos) * 2048 + h * 64;
    bf16x8 qr[4];
#pragma unroll
    for (int d0 = 0; d0 < 4; ++d0) qr[d0] = *(const bf16x8*)(Qrow + d0 * 16 + hi * 8);
    const bf16_t* Kb = KF + (size_t)(b * NKVH + kv) * 131072; const bf16_t* Vb = VF + (size_t)(b * NKVH + kv) * 131072;
    f32x16 o[2]; o[0] = f32x16{}; o[1] = f32x16{};
    float m = sink2, l = hi ? 0.f : 1.f;
    const int klo = c >= 4 ? c - 4 : 0;
    bf16x8 kc[4], kn[4], vc[4], vn[4];
    int kb = c;
    load_kb(kc, Kb, kb, lane); load_vb(vc, Vb, kb, lane);
#pragma unroll 1
    for (;;) {
        const int kp = kb > klo ? kb - 1 : klo;
        load_kb(kn, Kb, kp, lane); load_vb(vn, Vb, kp, lane);
        f32x16 p = {};
#pragma unroll
        for (int d0 = 0; d0 < 4; ++d0) p = MFMA32(kc[d0], qr[d0], p);
        const float dbase = (float)(qpos - 32 * kb - 4 * hi), sbase = slope2 * dbase;
#pragma unroll
        for (int r = 0; r < 16; ++r) p[r] = __builtin_fmaf(slope2, (float)((r & 3) + 8 * (r >> 2)), p[r]) - sbase;
        if (kb == c) {
#pragma unroll
            for (int r = 0; r < 16; ++r) p[r] = ((float)((r & 3) + 8 * (r >> 2)) <= dbase) ? p[r] : -INFINITY;
        } else if (kb + 4 == c) {
            const float dlim = dbase - 128.f;
#pragma unroll
            for (int r = 0; r < 16; ++r) p[r] = ((float)((r & 3) + 8 * (r >> 2)) > dlim) ? p[r] : -INFINITY;
        }
        float r0 = fmaxf(p[0], p[1]), r1 = fmaxf(p[2], p[3]);
#pragma unroll
        for (int r = 4; r < 16; r += 4) { r0 = fmaxf(r0, fmaxf(p[r], p[r + 1])); r1 = fmaxf(r1, fmaxf(p[r + 2], p[r + 3])); }
        float rm = fmaxf(r0, r1);
        rm = fmaxf(rm, __shfl_xor(rm, 32));
        if (__any(rm > m)) {
            const float mn = fmaxf(m, rm), f = __builtin_amdgcn_exp2f(m - mn); m = mn; l *= f;
#pragma unroll
            for (int r = 0; r < 16; ++r) { const float fr_ = __shfl(f, crow(r, hi)); o[0][r] *= fr_; o[1][r] *= fr_; }
        }
        float l0 = 0.f, l1 = 0.f;
#pragma unroll
        for (int r = 0; r < 16; r += 2) { p[r] = __builtin_amdgcn_exp2f(p[r] - m); p[r + 1] = __builtin_amdgcn_exp2f(p[r + 1] - m); l0 += p[r]; l1 += p[r + 1]; }
        l += l0 + l1;
        pv_block(o, p, vc);
        if (kb == klo) break;
        --kb;
#pragma unroll
        for (int i = 0; i < 4; ++i) { kc[i] = kn[i]; vc[i] = vn[i]; }
    }
    l += __shfl_xor(l, 32);
    const float inv = 1.0f / l;
#pragma unroll
    for (int r = 0; r < 16; ++r) { const float ir = __shfl(inv, crow(r, hi)); o[0][r] *= ir; o[1][r] *= ir; }
    store_o(o, Y + (size_t)(b * SEQ + q0) * 2048 + h * 64, ssqy + (size_t)(b * SEQ + q0) * 2, stg, lane);
}

#define XB_TMO      128
#define XB_XCNT(j)  (256  + 64 * (j))
#define XB_XSUB(j)  (1280 + 64 * (j))
#define XB_XGEN(j)  (2304 + 64 * (j))
#define XB_TOP      3328
#define XB_TOPGEN   3392
#define XCD_BAR_WORDS 3456
#define XB_SPIN_CAP (1u << 18)

__device__ __forceinline__ unsigned xb_ld(unsigned* p)              { return __hip_atomic_load(p, __ATOMIC_RELAXED, __HIP_MEMORY_SCOPE_AGENT); }
__device__ __forceinline__ unsigned xb_add(unsigned* p, unsigned v) { return __hip_atomic_fetch_add(p, v, __ATOMIC_RELAXED, __HIP_MEMORY_SCOPE_AGENT); }
__device__ __forceinline__ unsigned xb_xcc_id() { return (unsigned)__builtin_amdgcn_s_getreg((3 << 11) | 20) & 0xFu; }
#define XB_SPIN(cond, bar) do { unsigned _sp = 0; while (cond) { __builtin_amdgcn_s_sleep(1); \
    if ((++_sp & 255u) == 0u) { if (xb_ld(&(bar)[XB_TMO])) break; if (_sp > XB_SPIN_CAP) { atomicAdd(&(bar)[XB_TMO], 1u); break; } } } } while (0)

struct XcdBarrier {
    unsigned* bar; unsigned x;
    volatile LAS unsigned* st;
};

__device__ __forceinline__ XcdBarrier xcd_barrier_post(unsigned* bar, volatile LAS unsigned* st, const bool t0  ) {
    XcdBarrier b; b.bar = bar; b.x = xb_xcc_id(); b.st = st;
    if (t0) (void)xb_add(&bar[XB_XCNT(b.x)], 1u);
    return b;
}
__device__ __forceinline__ void xcd_barrier_complete(unsigned* bar, unsigned x, unsigned& nloc, unsigned& nx) {
    const unsigned G = gridDim.x * gridDim.y * gridDim.z;
    unsigned sum, cnt, mine, sp = 0u;
    for (;;) {
        sum = 0u; cnt = 0u; mine = 0u;
#pragma unroll
        for (unsigned j = 0; j < 16; ++j) { const unsigned c = xb_ld(&bar[XB_XCNT(j)]); sum += c; cnt += (c > 0u) ? 1u : 0u; mine = (j == x) ? c : mine; }
        if (sum == G) break;
        __builtin_amdgcn_s_sleep(1);
        if ((++sp & 255u) == 0u) { if (xb_ld(&bar[XB_TMO])) break; if (sp > XB_SPIN_CAP) { atomicAdd(&bar[XB_TMO], 1u); break; } }
    }
    nloc = mine > 0u ? mine : 1u; nx = cnt > 0u ? cnt : 1u;
}

__device__ __forceinline__ void xcd_barrier(const XcdBarrier& b, const bool t0  ) {
    asm volatile("s_waitcnt vmcnt(0)" ::: "memory");
    __syncthreads();
    if (t0) {
        unsigned* bar = b.bar;
        __builtin_amdgcn_s_waitcnt(0);
        unsigned nloc = b.st[0], nx = b.st[1];
        if (nloc == 0u) { xcd_barrier_complete(bar, b.x, nloc, nx); b.st[0] = nloc; b.st[1] = nx; }
        const unsigned old = xb_add(&bar[XB_XSUB(b.x)], 1u);
        const unsigned gen = old / nloc;
        if (old + 1u == (gen + 1u) * nloc) {
            __builtin_amdgcn_fence(__ATOMIC_RELEASE, "agent");
            asm volatile("s_waitcnt vmcnt(0)" ::: "memory");
            const unsigned og = xb_add(&bar[XB_TOP], 1u);
            const unsigned tg = og / nx;
            if (og + 1u == (tg + 1u) * nx) xb_add(&bar[XB_TOPGEN], 1u);
            else XB_SPIN(xb_ld(&bar[XB_TOPGEN]) == tg, bar);
            __builtin_amdgcn_fence(__ATOMIC_ACQUIRE, "agent");
            xb_add(&bar[XB_XGEN(b.x)], 1u);
            asm volatile("s_waitcnt vmcnt(0)" ::: "memory");
        } else {
            XB_SPIN(xb_ld(&bar[XB_XGEN(b.x)]) == gen, bar);
            __builtin_amdgcn_fence(__ATOMIC_ACQUIRE, "agent");
            asm volatile("s_waitcnt vmcnt(0)" ::: "memory");
        }
    }
    __syncthreads();
}

__device__ __forceinline__ int fresh_lane() { return pg8::lane_id(); }
struct Args { const float* in[16]; float* out; unsigned char* ws; };
__global__ void __launch_bounds__(NWAVES * 64, 2) hybrid_fwd(Args args) {
    extern __shared__ __attribute__((aligned(16))) unsigned char lds_raw[];
    LAS unsigned char* lds = (LAS unsigned char*)lds_raw;
    cg::grid_group grid = cg::this_grid();
    const int wave = __builtin_amdgcn_readfirstlane((int)threadIdx.x >> 6);
#define T0() (wave == 0 && pg8::lane_id() == 0)
    volatile LAS unsigned* bst = (volatile LAS unsigned*)(lds + LDS_STAGE);
    if (wave == 0) { const int l_ = pg8::lane_id(); if (l_ < 2) bst[l_] = 0u; }
    __syncthreads();
    const XcdBarrier xbar = xcd_barrier_post((unsigned*)(args.ws + WS_CTL), bst, T0());
    const int G = gridDim.x, gw = blockIdx.x * NWAVES + wave, NGW = G * NWAVES;
    unsigned char* ws = args.ws;
    const float* x = args.in[0];
    float* out = args.out;
    bf16_t* WGU1 = (bf16_t*)(ws + WS_WGU1); bf16_t* WD1 = (bf16_t*)(ws + WS_WD1); bf16_t* WIN = (bf16_t*)(ws + WS_WIN); bf16_t* WOUT = (bf16_t*)(ws + WS_WOUT);
    bf16_t* WGU2 = (bf16_t*)(ws + WS_WGU2); bf16_t* WD2 = (bf16_t*)(ws + WS_WD2);
    bf16_t* HN = (bf16_t*)(ws + WS_HN); bf16_t* HB = (bf16_t*)(ws + WS_H); bf16_t* QB = (bf16_t*)(ws + WS_Q); bf16_t* KF = (bf16_t*)(ws + WS_KF); bf16_t* VF = (bf16_t*)(ws + WS_VF);
    bf16_t* YB = (bf16_t*)(ws + WS_Y);
    float* ssq1 = (float*)(ws + WS_SSQ); float* ssq2 = ssq1 + MTOK; float* ssqy = ssq2 + MTOK; float* ssq3 = ssqy + 2 * MTOK;
    unsigned char* X2F8 = ws + WS_X2F8; bf16_t* X2B = (bf16_t*)(ws + WS_X2B);

    {
        const int lane = pg8::lane_id(), tid = wave * 64 + lane;
        constexpr int I_GU = 43 * 32, I_DN = 16 * 86, I_IN = 36 * 32, I_OUT = 16 * 32;
        constexpr int NITEMS = 4 * I_GU + 2 * I_DN + I_IN + I_OUT;
        for (int it = gw; it < NITEMS; it += NGW) {
            int r = it;
            if (r < I_GU) { transpose_item(args.in[2], DM, DFF, WGU1, 1, r, lane); continue; } r -= I_GU;
            if (r < I_GU) { transpose_item(args.in[3], DM, DFF, WGU1, 2, r, lane); continue; } r -= I_GU;
            if (r < I_DN) { transpose_item(args.in[4], DFF, DM, WD1, 0, r, lane, nullptr, nullptr, 0, DFF / 64); continue; } r -= I_DN;
            if (r < I_IN) { transpose_item(args.in[6], DM, 4608, WIN, 3, r, lane, args.in[5]); continue; } r -= I_IN;
            if (r < I_OUT) { transpose_item(args.in[10], DM, DM, WOUT, 0, r, lane, args.in[8], args.in[9]); continue; } r -= I_OUT;
            if (r < I_GU) { transpose_item<true>(args.in[12], DM, DFF, WGU2, 1, r, lane, args.in[11]); continue; } r -= I_GU;
            if (r < I_GU) { transpose_item<true>(args.in[13], DM, DFF, WGU2, 2, r, lane, args.in[11]); continue; } r -= I_GU;
            transpose_item(args.in[14], DFF, DM, WD2, 0, r, lane, nullptr, nullptr, 0, DFF / 64);
        }
        for (int m = gw; m < MTOK; m += NGW) rms_row_bf16(x + (size_t)m * DM, args.in[1], HN + (size_t)m * DM, lane);
        for (int i = blockIdx.x * (NWAVES * 64) + tid; i < 5 * MTOK; i += G * NWAVES * 64) ssq1[i] = 0.f;
    }
    grid.sync();
    {
        pg8::Gemm g{HN, WGU1, MTOK, 2 * DFF, DM, DM, 0}; pg8::StaticOrder S; S.init(MTOK, 2 * DFF, G, (int)blockIdx.x);
        pg8::EpiSwiglu E{HB, LDH, nullptr, 1.0f, DFF / 64};
        pg8::gemm_phase<pg8::EpiSwiglu, pg8::StaticOrder, true, true>(lds, g, S, E, wave);
    }
    xcd_barrier(xbar, T0());
    {
        pg8::Gemm g{HB, WD1, MTOK, DM, DFF, LDH, 2}; pg8::StaticOrder S; S.init(MTOK, DM, G, (int)blockIdx.x, 1);
        pg8::EpiResidStat<false, false, false, true, false> E{x, nullptr, HN, nullptr, ssq1, 0.5f, nullptr};
        pg8::gemm_phase<pg8::EpiResidStat<false, false, false, true, false>, pg8::StaticOrder, true, true>(lds, g, S, E, wave);
    }
    xcd_barrier(xbar, T0());
    {
        pg8::Gemm g{HN, WIN, MTOK, NQK, DM, DM, 0}; pg8::InProjOrder S; S.init(MTOK, NQK, NVT, G, (int)blockIdx.x, HN, WIN, DM);
        pg8::EpiInProj E{pg8::EpiQK{QB, KF, QSCALE, ssq1}, pg8::EpiVT{VF, ssq1}};
        pg8::gemm_phase<pg8::EpiInProj, pg8::InProjOrder, true, true>(lds, g, S, E, wave);
    }
    xcd_barrier(xbar, T0());
    { const int lane5 = fresh_lane();
    for (int pi = gw; pi < NBATCH * 16 * 8; pi += NGW) {
        const int bh = pi >> 3, s = pi & 7, b = bh >> 4, h = bh & 15;
#pragma unroll 1
        for (int i = 0; i < 8; ++i) { const int c = 16 * (i >> 1) + ((i & 1) ? 15 - s : s); sb_item(b, h, c, QB, KF, VF, YB, ssqy, lds + wave * 4096, lane5); }
        const float sink2 = args.in[7][h] * LOG2E, slope2 = __builtin_amdgcn_exp2f(-0.5f * (float)(h + 1)) * LOG2E;
#pragma unroll 1
        for (int i = 0; i < 8; ++i) { const int c = 16 * (i >> 1) + ((i & 1) ? 15 - s : s); swa_item(b, h, c, QB, KF, VF, YB, ssqy, sink2, slope2, lds + wave * 4096, lane5); }
    }
    }
    xcd_barrier(xbar, T0());
    {
        pg8::Gemm g{YB, WOUT, MTOK, DM, DM, DM, 0}; pg8::StaticOrder S; S.init(MTOK, DM, G, (int)blockIdx.x);
        pg8::EpiResidStat<true, true, false, true, true> E{HN, nullptr, X2B, X2F8, ssq2, 1.0f, ssqy};
        pg8::gemm_phase<pg8::EpiResidStat<true, true, false, true, true>, pg8::StaticOrder, true, true>(lds, g, S, E, wave);
    }
    xcd_barrier(xbar, T0());
    {
        pg8::Gemm g{(const bf16_t*)X2F8, WGU2, MTOK, 2 * DFF, DM / 2, DM / 2, 0}; pg8::StaticOrder S; S.init(MTOK, 2 * DFF, G, (int)blockIdx.x);
        pg8::EpiSwiglu E{HB, LDH, ssq2, 1.0f / W8_SCALE, DFF / 64};
        pg8::gemm_phase<pg8::EpiSwiglu, pg8::StaticOrder, true, true, true>(lds, g, S, E, wave);
    }
    xcd_barrier(xbar, T0());
    {
        pg8::Gemm g{HB, WD2, MTOK, DM, DFF, LDH, 2}; pg8::StaticOrder S; S.init(MTOK, DM, G, (int)blockIdx.x, 1);
        pg8::EpiResidStat<false, true, false, true, false> E{X2B, nullptr, HN, nullptr, ssq3, 0.5f, nullptr};
        pg8::gemm_phase<pg8::EpiResidStat<false, true, false, true, false>, pg8::StaticOrder, true, true>(lds, g, S, E, wave);
    }
    xcd_barrier(xbar, T0());
    { const int lane11 = fresh_lane();
    for (int m = gw; m < MTOK; m += NGW) final_row(HN + (size_t)m * DM, ssq3[m], args.in[15], out + (size_t)m * DM, lane11); }
}

extern "C" void kernel_launch(void* const* d_in, const int* in_sizes, int n_in, void* d_out, int out_size, void* d_ws, size_t ws_size, hipStream_t stream) {
    static int grid_blocks = 0;
    if (grid_blocks == 0) {
        if (n_in != 16 || in_sizes[0] != MTOK * DM || out_size != MTOK * DM || ws_size < WS_END) {
            fprintf(stderr, "kernel_launch: unexpected shapes (n_in %d in0 %d out %d ws %zu)\n", n_in, n_in > 0 ? in_sizes[0] : -1, out_size, ws_size); grid_blocks = -1; return; }
        int dev = 0, cus = 0, per_cu = 0;
        hipGetDevice(&dev);
        hipDeviceGetAttribute(&cus, hipDeviceAttributeMultiprocessorCount, dev);
        hipFuncSetAttribute((const void*)hybrid_fwd, hipFuncAttributeMaxDynamicSharedMemorySize, LDS_BYTES);
        hipOccupancyMaxActiveBlocksPerMultiprocessor(&per_cu, (const void*)hybrid_fwd, NWAVES * 64, LDS_BYTES);
        if (per_cu < 1) { fprintf(stderr, "kernel_launch: occupancy query says %d blocks/CU\n", per_cu); per_cu = 1; }
        grid_blocks = cus * per_cu;
    }
    if (grid_blocks < 0) return;
    if (hipMemsetAsync((char*)d_ws + WS_CTL, 0, CTL_BYTES, stream) != hipSuccess) { fprintf(stderr, "kernel_launch: hipMemsetAsync failed\n"); return; }
    Args a{};
    for (int i = 0; i < 16; ++i) a.in[i] = (const float*)d_in[i];
    a.out = (float*)d_out; a.ws = (unsigned char*)d_ws;
    void* kargs[] = {&a};
    hipError_t e = hipLaunchCooperativeKernel((const void*)hybrid_fwd, dim3(grid_blocks), dim3(NWAVES * 64), kargs, LDS_BYTES, stream);
    if (e != hipSuccess) fprintf(stderr, "cooperative launch failed: %s (grid %d)\n", hipGetErrorString(e), grid_blocks);
}
```

```cpp
#include <hip/hip_runtime.h>
#include <hip/hip_cooperative_groups.h>
#include <cstdio>
#include <cstdint>
#include <type_traits>
namespace cg = cooperative_groups;
namespace pg8 {
#define PG8_LAS __attribute__((address_space(3)))
typedef unsigned short bf16_t;
typedef short bf16x8 __attribute__((ext_vector_type(8)));
typedef float f32x4 __attribute__((ext_vector_type(4)));
typedef unsigned u32x4 __attribute__((ext_vector_type(4)));
typedef int i32x4 __attribute__((ext_vector_type(4)));
typedef int i32x8 __attribute__((ext_vector_type(8)));
__device__ __forceinline__ int lane_id() { int l; asm volatile("v_mbcnt_lo_u32_b32 %0, -1, 0\n\tv_mbcnt_hi_u32_b32 %0, -1, %0" : "=v"(l)); return l; }
constexpr int BM = 256, BK = 64, HALF = 128, HTB = HALF * BK * 2  , STAGE_BYTES = 8 * HTB, NXCD = 8, WGM = 8;

__host__ __device__ __forceinline__ int lds_byte(int r, int c) { const int st = (r >> 4) * 2 + (c >> 5), rr = r & 15, cc = c & 31, ob = rr * 64 + cc * 2; return st * 1024 + (ob ^ (((ob >> 9) & 1) << 5)); }
__host__ __device__ __forceinline__ void stage_rc(int b, int& R, int& C) { const int st = b / 1024, sb = b % 1024, swz = sb ^ (((sb >> 9) & 1) << 5); R = (st >> 1) * 16 + swz / 64; C = (st & 1) * 32 + (swz % 64) / 2; }
__host__ __device__ __forceinline__ int perm32(int rho) { const int n = rho >> 4, i = rho & 15; return 8 * (i >> 2) + 4 * n + (i & 3); }

struct Unit { int pm, pn, ty; };
__host__ __device__ __forceinline__ int invperm32(int s) { return 16 * ((s >> 2) & 1) + 4 * (s >> 3) + (s & 3); }
struct Gemm { const bf16_t* A; const bf16_t* Bt; int M, N, K, ld, blk; };

struct StaticOrder {
    int nM, nN, nwg, G, c, rev;
    __host__ __device__ void init(int M, int N, int G_, int c_, int rev_ = 0) { nM = M / BM; nN = N / BM; nwg = nM * nN; G = G_; c = c_; rev = rev_; }
    __host__ __device__ bool next(int i, Unit& u) const {
        const long L = (long)i * G + c; if (L >= nwg) return false;
        u.ty = 0; map((int)L, u); return true;
    }
    __host__ __device__ void map(int L, Unit& u) const {
        int wgid = L; { const int q = nwg / NXCD, r = nwg % NXCD, xcd = wgid % NXCD, off = wgid / NXCD; wgid = (xcd < r ? xcd * (q + 1) : r * (q + 1) + (xcd - r) * q) + off; }
        const int nig = WGM * nN, gid = wgid / nig, fm = gid * WGM, gsz = (nM - fm) < WGM ? (nM - fm) : WGM;
        u.pm = fm + ((wgid % nig) % gsz); u.pn = (wgid % nig) / gsz; if (rev) u.pm = nM - 1 - u.pm;
    }
    __device__ __forceinline__ const char* pa(const Gemm& g, const Unit& u, size_t tstep) const { return (const char*)g.A + (size_t)u.pm * tstep; }
    __device__ __forceinline__ const char* pb(const Gemm& g, const Unit& u, size_t tstep) const { return (const char*)g.Bt + (size_t)u.pn * tstep; }
    __device__ __forceinline__ void a_ready(const Unit&) const {}
    __device__ __forceinline__ void done(const Unit&) const {}
};

__device__ __forceinline__ unsigned cvt_pk_bf16(float lo, float hi) { unsigned r; asm volatile("v_cvt_pk_bf16_f32 %0, %1, %2" : "=v"(r) : "v"(lo), "v"(hi)); return r; }
typedef float f32x2 __attribute__((ext_vector_type(2)));
typedef unsigned u32x2 __attribute__((ext_vector_type(2)));
typedef float f32x2 __attribute__((ext_vector_type(2)));
__device__ __forceinline__ unsigned pk4_fp8(float a, float b, float c, float d) {
    a = fminf(fmaxf(a, -448.f), 448.f); b = fminf(fmaxf(b, -448.f), 448.f); c = fminf(fmaxf(c, -448.f), 448.f); d = fminf(fmaxf(d, -448.f), 448.f);
    unsigned w = 0; w = __builtin_amdgcn_cvt_pk_fp8_f32(a, b, w, false); w = __builtin_amdgcn_cvt_pk_fp8_f32(c, d, w, true); return w; }
__device__ __forceinline__ float silu_mul(float g, float u) { return g * __builtin_amdgcn_rcpf(1.0f + __builtin_amdgcn_exp2f(-1.4426950408889634f * g)) * u; }

struct EpiSwiglu {
    static constexpr bool PERM = true, AFTER_DRAIN = false, MIDHOOK = false;
    bf16_t* O; int ldc; const float* ssq; float oscale; int nt_blk;
    __device__ __forceinline__ void operator()(const f32x4 (&acc)[2][2][4][2], const Unit& u, int wr, int wc, int fr, int fq) const {
        const int row0 = u.pm * BM + wr * 64 + fr, col0 = u.pn * HALF + wc * 32 + 8 * fq;
#pragma unroll
        for (int ai = 0; ai < 2; ++ai)
#pragma unroll
            for (int m = 0; m < 4; ++m) {
                bf16_t* rowp = nt_blk ? O + (((size_t)u.pm * nt_blk + (col0 >> 6)) * 2 + ai) * (HALF * BK) + (lds_byte(wr * 64 + fr + m * 16, col0 & 63) >> 1)
                                      : O + (size_t)(row0 + ai * HALF + m * 16) * ldc + col0;
                const float rs = (ssq ? rsqrtf(ssq[row0 + ai * HALF + m * 16] * (1.f / 2048.f) + 1e-6f) : 1.f) * oscale;
                const float nrl = -1.4426950408889634f * rs, rs2 = rs * rs;
                u32x4 w;
#pragma unroll
                for (int n = 0; n < 2; ++n)
#pragma unroll
                    for (int hh = 0; hh < 2; ++hh) {
                        const f32x2 g = {acc[ai][0][m][n][2 * hh], acc[ai][0][m][n][2 * hh + 1]}, uu = {acc[ai][1][m][n][2 * hh], acc[ai][1][m][n][2 * hh + 1]};
                        const f32x2 t = g * nrl; f32x2 ex; ex.x = __builtin_amdgcn_exp2f(t.x); ex.y = __builtin_amdgcn_exp2f(t.y);
                        const f32x2 d = ex + 1.0f; f32x2 r; r.x = __builtin_amdgcn_rcpf(d.x); r.y = __builtin_amdgcn_rcpf(d.y);
                        const f32x2 o = (g * uu) * (r * rs2);
                        w[2 * n + hh] = cvt_pk_bf16(o.x, o.y);
                    }
                __builtin_nontemporal_store(w, (u32x4*)rowp);
            }
    }
};
struct EpiResid {
    static constexpr bool PERM = false, AFTER_DRAIN = false, MIDHOOK = false;
    const float* base; float* out; float scale;
    __device__ __forceinline__ void operator()(const f32x4 (&acc)[2][2][4][2], const Unit& u, int wr, int wc, int fr, int fq) const {
        const int col0 = u.pn * BM + wc * 32 + 4 * fq;
#pragma unroll
        for (int ai = 0; ai < 2; ++ai)
#pragma unroll
            for (int m = 0; m < 4; ++m) { const size_t off = (size_t)(u.pm * BM + ai * HALF + wr * 64 + m * 16 + fr) * 2048 + col0;
#pragma unroll
                for (int bj = 0; bj < 2; ++bj)
#pragma unroll
                    for (int n = 0; n < 2; ++n) { const f32x4 bs = *(const f32x4*)(base + off + bj * HALF + n * 16); *(f32x4*)(out + off + bj * HALF + n * 16) = bs + acc[ai][bj][m][n] * scale; } }
    }
};
struct EpiQK {
    static constexpr bool PERM = true, AFTER_DRAIN = false, MIDHOOK = false;
    bf16_t* Q; bf16_t* KF; float qscale; const float* ssq;
    __device__ __forceinline__ void operator()(const f32x4 (&acc)[2][2][4][2], const Unit& u, int wr, int wc, int fr, int fq) const {
        const int row0 = u.pm * BM + wr * 64 + fr;
        if (u.pn < 8) {
            const int col0 = u.pn * BM + wc * 32 + 8 * fq;
#pragma unroll
            for (int ai = 0; ai < 2; ++ai)
#pragma unroll
                for (int m = 0; m < 4; ++m) { bf16_t* rowp = Q + (size_t)(row0 + ai * HALF + m * 16) * 2048 + col0; const float rs = qscale * rsqrtf(ssq[row0 + ai * HALF + m * 16] * (1.f / 2048.f) + 1e-6f);
#pragma unroll
                    for (int bj = 0; bj < 2; ++bj) { const f32x4 v0 = acc[ai][bj][m][0] * rs, v1 = acc[ai][bj][m][1] * rs;
                        u32x4 w; w.x = cvt_pk_bf16(v0[0], v0[1]); w.y = cvt_pk_bf16(v0[2], v0[3]); w.z = cvt_pk_bf16(v1[0], v1[1]); w.w = cvt_pk_bf16(v1[2], v1[3]);
                        *(u32x4*)(rowp + bj * HALF) = w; } }
        } else {
#pragma unroll
            for (int bj = 0; bj < 2; ++bj) {
                const int kcol = (u.pn - 8) * BM + bj * HALF + wc * 32 + 8 * fq, kh = kcol >> 6, chunk = (kcol & 63) >> 3;
#pragma unroll
                for (int ai = 0; ai < 2; ++ai)
#pragma unroll
                    for (int m = 0; m < 4; ++m) { const int r = row0 + ai * HALF + m * 16, b = r >> 11, t = r & 2047;
                        bf16_t* p = KF + (size_t)(b * 20 + kh) * 131072 + (size_t)((t >> 5) * 8 + chunk) * 256 + (t & 31) * 8;
                        const float rs = rsqrtf(ssq[r] * (1.f / 2048.f) + 1e-6f);
                        const f32x4 v0 = acc[ai][bj][m][0] * rs, v1 = acc[ai][bj][m][1] * rs;
                        u32x4 w; w.x = cvt_pk_bf16(v0[0], v0[1]); w.y = cvt_pk_bf16(v0[2], v0[3]); w.z = cvt_pk_bf16(v1[0], v1[1]); w.w = cvt_pk_bf16(v1[2], v1[3]);
                        *(u32x4*)p = w; }
            }
        }
    }
};
struct EpiVT {
    static constexpr bool PERM = true, AFTER_DRAIN = false, MIDHOOK = false;
    bf16_t* VF; const float* ssq;
    __device__ __forceinline__ void operator()(const f32x4 (&acc)[2][2][4][2], const Unit& u, int wr, int wc, int fr, int fq) const {
#pragma unroll
        for (int bj = 0; bj < 2; ++bj) {
            const int tok = u.pn * BM + bj * HALF + wc * 32 + 8 * fq, b = tok >> 11, t = tok & 2047, g = t >> 4, ih = (t & 15) >> 3;
            f32x4 rs0 = *(const f32x4*)(ssq + tok), rs1 = *(const f32x4*)(ssq + tok + 4);
#pragma unroll
            for (int e_ = 0; e_ < 4; ++e_) { rs0[e_] = rsqrtf(rs0[e_] * (1.f / 2048.f) + 1e-6f); rs1[e_] = rsqrtf(rs1[e_] * (1.f / 2048.f) + 1e-6f); }
#pragma unroll
            for (int ai = 0; ai < 2; ++ai)
#pragma unroll
                for (int m = 0; m < 4; ++m) { const int r = u.pm * BM + ai * HALF + wr * 64 + m * 16 + fr, vh = r >> 6, d = r & 63, d0 = d >> 5, dl = d & 31;
                    bf16_t* p = VF + (size_t)(b * 20 + vh) * 131072 + (size_t)((g * 2 + d0) * 2) * 256 + dl * 8 + ih * 4;
                    const f32x4 v0 = acc[ai][bj][m][0] * rs0, v1 = acc[ai][bj][m][1] * rs1;
                    u32x2 w0, w1; w0.x = cvt_pk_bf16(v0[0], v0[1]); w0.y = cvt_pk_bf16(v0[2], v0[3]); w1.x = cvt_pk_bf16(v1[0], v1[1]); w1.y = cvt_pk_bf16(v1[2], v1[3]);
                    *(u32x2*)p = w0;
                    *(u32x2*)(p + 256) = w1; }
        }
    }
};

struct InProjOrder {
    StaticOrder qk, vt; int nqk, ntot, G, c; const bf16_t* X; const bf16_t* Wqk; const bf16_t* Wv;
    __device__ void init(int M, int NQK_, int NVT_, int G_, int c_, const bf16_t* X_, const bf16_t* W_, int K) {
        qk.init(M, NQK_, G_, c_); vt.init(NVT_, M, G_, c_); nqk = qk.nwg; ntot = qk.nwg + vt.nwg; G = G_; c = c_; X = X_; Wqk = W_; Wv = W_ + (size_t)NQK_ * K; }
    __device__ bool next(int i, Unit& u) const { const long L = (long)i * G + c; if (L >= ntot) return false;
        if (L < nqk) { u.ty = 0; qk.map((int)L, u); } else { u.ty = 1; vt.map((int)L - nqk, u); } return true; }
    __device__ __forceinline__ const char* pa(const Gemm&, const Unit& u, size_t tstep) const { return (const char*)(u.ty ? Wv : X) + (size_t)u.pm * tstep; }
    __device__ __forceinline__ const char* pb(const Gemm&, const Unit& u, size_t tstep) const { return (const char*)(u.ty ? X : Wqk) + (size_t)u.pn * tstep; }
    __device__ __forceinline__ void a_ready(const Unit&) const {}
    __device__ __forceinline__ void done(const Unit&) const {}
};
struct EpiInProj {
    static constexpr bool PERM = true, AFTER_DRAIN = false, MIDHOOK = false;
    EpiQK qk; EpiVT vt;
    __device__ __forceinline__ void operator()(const f32x4 (&acc)[2][2][4][2], const Unit& u, int wr, int wc, int fr, int fq) const { if (u.ty == 0) qk(acc, u, wr, wc, fr, fq); else vt(acc, u, wr, wc, fr, fq); }
};

template <bool MID, bool BASE16, bool F32OUT, bool W16, bool W8> struct EpiResidStat {
    static constexpr bool PERM = true, AFTER_DRAIN = false, MIDHOOK = MID;
    const void* base; float* out; bf16_t* xb16; unsigned char* xb8; float* ssq; float scale; const float* ssqy;
    __device__ __forceinline__ void mid(f32x4 (&acc)[2][2][4][2], const Unit& u, int wr, int wc, int fr, int fq) const {
#pragma unroll
        for (int ai = 0; ai < 2; ++ai)
#pragma unroll
            for (int m = 0; m < 4; ++m) { const int r = u.pm * BM + ai * HALF + wr * 64 + m * 16 + fr; const f32x2 sy = *(const f32x2*)(ssqy + 2 * r);
                const float ratio = rsqrtf(sy.x * (1.f / 1024.f) + 1e-6f) * sqrtf(sy.y * (1.f / 1024.f) + 1e-6f);
#pragma unroll
                for (int bj = 0; bj < 2; ++bj)
#pragma unroll
                    for (int n = 0; n < 2; ++n) acc[ai][bj][m][n] *= ratio; }
    }
    __device__ __forceinline__ void operator()(const f32x4 (&acc)[2][2][4][2], const Unit& u, int wr, int wc, int fr, int fq) const {
        const int col0 = u.pn * BM + wc * 32 + 8 * fq;
#pragma unroll
        for (int ai = 0; ai < 2; ++ai) {
            u32x4 b16[4][2]; f32x4 b32[4][2][2]; float sy[4];
#pragma unroll
            for (int m = 0; m < 4; ++m) { const int r = u.pm * BM + ai * HALF + wr * 64 + m * 16 + fr; const size_t off = (size_t)r * 2048 + col0;
                if (MID) sy[m] = ssqy[2 * r + 1];
#pragma unroll
                for (int bj = 0; bj < 2; ++bj) { const size_t o = off + bj * HALF;
                    if constexpr (BASE16) b16[m][bj] = *(const u32x4*)((const bf16_t*)base + o);
                    else { b32[m][bj][0] = *(const f32x4*)((const float*)base + o); b32[m][bj][1] = *(const f32x4*)((const float*)base + o + 4); } } }
#pragma unroll
            for (int m = 0; m < 4; ++m) { const int r = u.pm * BM + ai * HALF + wr * 64 + m * 16 + fr; const size_t off = (size_t)r * 2048 + col0;
                float sc = scale; if (MID) sc *= rsqrtf(sy[m] * (1.f / 1024.f) + 1e-6f);
                float s = 0.f;
#pragma unroll
                for (int bj = 0; bj < 2; ++bj) { const size_t o = off + bj * HALF;
                    f32x4 bs0, bs1;
                    if constexpr (BASE16) { const u32x4 bw = b16[m][bj];
                        bs0 = (f32x4){__uint_as_float(bw.x << 16), __uint_as_float(bw.x & 0xffff0000u), __uint_as_float(bw.y << 16), __uint_as_float(bw.y & 0xffff0000u)};
                        bs1 = (f32x4){__uint_as_float(bw.z << 16), __uint_as_float(bw.z & 0xffff0000u), __uint_as_float(bw.w << 16), __uint_as_float(bw.w & 0xffff0000u)}; }
                    else { bs0 = b32[m][bj][0]; bs1 = b32[m][bj][1]; }
                    const f32x4 v0 = bs0 + acc[ai][bj][m][0] * sc, v1 = bs1 + acc[ai][bj][m][1] * sc;
                    if constexpr (F32OUT) { *(f32x4*)(out + o) = v0; *(f32x4*)(out + o + 4) = v1; }
                    s += ((v0[0] * v0[0] + v0[1] * v0[1]) + (v0[2] * v0[2] + v0[3] * v0[3])) + ((v1[0] * v1[0] + v1[1] * v1[1]) + (v1[2] * v1[2] + v1[3] * v1[3]));
                    if constexpr (W16) { u32x4 w; w.x = cvt_pk_bf16(v0[0], v0[1]); w.y = cvt_pk_bf16(v0[2], v0[3]); w.z = cvt_pk_bf16(v1[0], v1[1]); w.w = cvt_pk_bf16(v1[2], v1[3]); *(u32x4*)(xb16 + o) = w; }
                    if constexpr (W8) { u32x2 w; w.x = pk4_fp8(v0[0], v0[1], v0[2], v0[3]); w.y = pk4_fp8(v1[0], v1[1], v1[2], v1[3]); *(u32x2*)(xb8 + o) = w; } }
                s += __shfl_xor(s, 16); s += __shfl_xor(s, 32);
                if (fq == 0) __hip_atomic_fetch_add(ssq + r, s, __ATOMIC_RELAXED, __HIP_MEMORY_SCOPE_AGENT); }
            asm volatile("" ::: "memory");
        }
    }
};
template <bool F> struct Frags { bf16x8 At[4][2], B0[2][2], B1[2][2]; };
template <> struct Frags<true> { i32x8 At[4], B0[2], B1[2]; };
template <class Epi, class Sched, bool ALIGN_EPI = false, bool SP2 = false, bool FP8 = false>
__device__ __forceinline__ void gemm_phase(PG8_LAS unsigned char* lds, const Gemm g, const Sched& S, const Epi& E, const int wave_s  ) {
    const int tid_ = wave_s * 64 + lane_id();
    const int tid = tid_, wid = wave_s, lane = tid & 63, wr = wid >> 2, wc = wid & 3, fr = lane & 15, fq = lane >> 4;
    const int K = g.K, nt = K / BK, LD = g.blk ? BK : g.ld;
    unsigned voffA[2], voffB[2];
#pragma unroll
    for (int i = 0; i < 2; ++i) { int R, C; stage_rc(tid * 16 + i * 8192, R, C); const int Rb = Epi::PERM ? ((R & ~31) + perm32(R & 31)) : R;
        voffA[i] = (unsigned)(R * LD + C) * 2u; voffB[i] = (unsigned)(Rb * LD + C) * 2u;
        if (g.blk == 2) { voffA[i] = (unsigned)(tid * 16 + i * 8192); voffB[i] = voffA[i]; } }
    const size_t kstep = g.blk ? (size_t)BM * BK * 2 : (size_t)(BK * 2);
    const size_t hstep = (size_t)HALF * LD * 2;
    const size_t tstep = g.blk ? (size_t)nt * BM * BK * 2 : 2 * hstep;
    const unsigned ldsw = (unsigned)wid * 1024u;
    const int aoff = lds_byte(wr * 64 + fr, fq * 8), boff = lds_byte(wc * 32 + fr, fq * 8);
#define PG8_SA(b, h) (((b) * 2 + (h)) * HTB)
#define PG8_SB(b, h) ((4 + (b) * 2 + (h)) * HTB)
#define PG8_STAGE(bufoff, gbase, voff) do { _Pragma("unroll") for (int _i = 0; _i < 2; ++_i) \
        __builtin_amdgcn_global_load_lds((const unsigned*)((const char*)(gbase) + (voff)[_i]), (PG8_LAS unsigned*)(lds + (bufoff) + ldsw + _i * 8192), 16, 0, 0); } while (0)
#define PG8_LDA(dst, b, h) do { if constexpr (FP8) { _Pragma("unroll") for (int m = 0; m < 4; ++m) dst[m] = __builtin_shufflevector(*(const PG8_LAS i32x4*)(lds + PG8_SA(b, h) + aoff + m * 2048), *(const PG8_LAS i32x4*)(lds + PG8_SA(b, h) + aoff + m * 2048 + 1024), 0, 1, 2, 3, 4, 5, 6, 7); } \
    else { _Pragma("unroll") for (int m = 0; m < 4; ++m) _Pragma("unroll") for (int k = 0; k < 2; ++k) dst[m][k] = *(const PG8_LAS bf16x8*)(lds + PG8_SA(b, h) + aoff + m * 2048 + k * 1024); } } while (0)
#define PG8_LDB(dst, b, h) do { if constexpr (FP8) { _Pragma("unroll") for (int n = 0; n < 2; ++n) dst[n] = __builtin_shufflevector(*(const PG8_LAS i32x4*)(lds + PG8_SB(b, h) + boff + n * 2048), *(const PG8_LAS i32x4*)(lds + PG8_SB(b, h) + boff + n * 2048 + 1024), 0, 1, 2, 3, 4, 5, 6, 7); } \
    else { _Pragma("unroll") for (int n = 0; n < 2; ++n) _Pragma("unroll") for (int k = 0; k < 2; ++k) dst[n][k] = *(const PG8_LAS bf16x8*)(lds + PG8_SB(b, h) + boff + n * 2048 + k * 1024); } } while (0)
#define PG8_CAT(x) __builtin_shufflevector(__builtin_bit_cast(i32x4, (x)[0]), __builtin_bit_cast(i32x4, (x)[1]), 0, 1, 2, 3, 4, 5, 6, 7)
#define PG8_MMA(ai, bj, At, Bt) do { __builtin_amdgcn_s_setprio(1); if constexpr (FP8) { _Pragma("unroll") for (int m = 0; m < 4; ++m) _Pragma("unroll") for (int n = 0; n < 2; ++n) \
        asm volatile("v_mfma_f32_16x16x128_f8f6f4 %0, %1, %2, %0" : "+v"(acc[ai][bj][m][n]) : "v"(Bt[n]), "v"(At[m])); } else { \
        _Pragma("unroll") for (int m = 0; m < 4; ++m) _Pragma("unroll") for (int n = 0; n < 2; ++n) _Pragma("unroll") for (int k = 0; k < 2; ++k) \
        acc[ai][bj][m][n] = __builtin_amdgcn_mfma_f32_16x16x32_bf16(Bt[n][k], At[m][k], acc[ai][bj][m][n], 0, 0, 0); } __builtin_amdgcn_s_setprio(0); } while (0)
#define PG8_WAIT_V(n) asm volatile("s_waitcnt vmcnt(" #n ")" ::: "memory")
#define PG8_WAIT_L(n) asm volatile("s_waitcnt lgkmcnt(" #n ")" ::: "memory")
#define PG8_BAR __builtin_amdgcn_s_barrier()
#define PG8_SCHED __builtin_amdgcn_sched_barrier(0)
    Unit cur, nxt; int ui = 0;
    if (!S.next(0, cur)) return;
    f32x4 acc[2][2][4][2];
#pragma unroll
    for (int a = 0; a < 2; ++a)
#pragma unroll
        for (int b = 0; b < 2; ++b)
#pragma unroll
            for (int m = 0; m < 4; ++m)
#pragma unroll
                for (int n = 0; n < 2; ++n) acc[a][b][m][n] = (f32x4){0.f, 0.f, 0.f, 0.f};
    Frags<FP8> frg_; auto& At = frg_.At; auto& B0 = frg_.B0; auto& B1 = frg_.B1;
    const char* cA = S.pa(g, cur, tstep); const char* cB = S.pb(g, cur, tstep);
    S.a_ready(cur);
    if constexpr (SP2) {
        PG8_STAGE(PG8_SB(0, 0), cB, voffB); PG8_STAGE(PG8_SB(0, 1), cB + hstep, voffB); PG8_STAGE(PG8_SA(0, 0), cA, voffA); PG8_STAGE(PG8_SA(0, 1), cA + hstep, voffA);
        if (wr == 1) PG8_BAR;
        PG8_WAIT_V(2); PG8_BAR;
        PG8_STAGE(PG8_SB(1, 0), cB + kstep, voffB); PG8_STAGE(PG8_SA(1, 0), cA + kstep, voffA); PG8_STAGE(PG8_SB(1, 1), cB + hstep + kstep, voffB);
        PG8_WAIT_V(6); PG8_BAR;
    } else {
        PG8_STAGE(PG8_SB(0, 0), cB, voffB); PG8_STAGE(PG8_SA(0, 0), cA, voffA); PG8_STAGE(PG8_SB(0, 1), cB + hstep, voffB); PG8_STAGE(PG8_SA(0, 1), cA + hstep, voffA);
        if (wr == 1) PG8_BAR;
        PG8_WAIT_V(4); PG8_BAR;
        PG8_STAGE(PG8_SB(1, 0), cB + kstep, voffB); PG8_STAGE(PG8_SA(1, 0), cA + kstep, voffA); PG8_STAGE(PG8_SB(1, 1), cB + hstep + kstep, voffB);
        PG8_WAIT_V(6); PG8_BAR;
    }
    for (;;) {
        const bool has_next = S.next(ui + 1, nxt);
        const char* nA = has_next ? S.pa(g, nxt, tstep) : cA; const char* nB = has_next ? S.pb(g, nxt, tstep) : cB;
        for (int t = 0; t < nt; t += 2) {
            if constexpr (Epi::MIDHOOK) { if (t == (nt >> 1)) E.mid(acc, cur, wr, wc, fr, fq); }
            const bool last = (t == nt - 2);
            const char* a1 = cA + (size_t)(t + 1) * kstep;
            const char* a2 = last ? nA : cA + (size_t)(t + 2) * kstep; const char* b2 = last ? nB : cB + (size_t)(t + 2) * kstep;
            const char* a3 = a2 + kstep; const char* b3 = b2 + kstep;
            if (last && has_next) S.a_ready(nxt);
            if constexpr (SP2) {
            PG8_LDB(B0, 0, 0); PG8_LDB(B1, 0, 1); PG8_SCHED; PG8_LDA(At, 0, 0); PG8_STAGE(PG8_SA(1, 1), a1 + hstep, voffA);
            PG8_WAIT_V(8); PG8_WAIT_L(0); PG8_BAR; PG8_MMA(0, 0, At, B0); PG8_MMA(0, 1, At, B1); PG8_BAR; PG8_SCHED;
            PG8_LDA(At, 0, 1); PG8_STAGE(PG8_SB(0, 0), b2, voffB); PG8_STAGE(PG8_SB(0, 1), b2 + hstep, voffB); PG8_STAGE(PG8_SA(0, 0), a2, voffA);
            PG8_WAIT_V(8); PG8_WAIT_L(0); PG8_BAR; PG8_MMA(1, 0, At, B0); PG8_MMA(1, 1, At, B1); PG8_BAR; PG8_SCHED;
            PG8_LDB(B0, 1, 0); PG8_LDB(B1, 1, 1); PG8_SCHED; PG8_LDA(At, 1, 0); PG8_STAGE(PG8_SA(0, 1), a2 + hstep, voffA);
            PG8_WAIT_V(8); PG8_WAIT_L(0); PG8_BAR; PG8_MMA(0, 0, At, B0); PG8_MMA(0, 1, At, B1); PG8_BAR; PG8_SCHED;
            PG8_LDA(At, 1, 1); PG8_STAGE(PG8_SB(1, 0), b3, voffB); PG8_STAGE(PG8_SB(1, 1), b3 + hstep, voffB); PG8_STAGE(PG8_SA(1, 0), a3, voffA);
            PG8_WAIT_V(8); PG8_WAIT_L(0); PG8_BAR; PG8_MMA(1, 0, At, B0); PG8_MMA(1, 1, At, B1); PG8_BAR; PG8_SCHED;
            } else {
            PG8_LDB(B0, 0, 0); PG8_SCHED; PG8_LDA(At, 0, 0); PG8_STAGE(PG8_SA(1, 1), a1 + hstep, voffA);
            PG8_WAIT_L(8); PG8_BAR; PG8_WAIT_L(0); PG8_MMA(0, 0, At, B0); PG8_BAR; PG8_SCHED;
            PG8_LDB(B1, 0, 1); PG8_STAGE(PG8_SB(0, 0), b2, voffB);
            PG8_BAR; PG8_WAIT_L(0); PG8_MMA(0, 1, At, B1); PG8_BAR;
            PG8_LDA(At, 0, 1); PG8_STAGE(PG8_SA(0, 0), a2, voffA);
            PG8_BAR; PG8_WAIT_L(0); PG8_MMA(1, 0, At, B0); PG8_BAR; PG8_SCHED;
            PG8_STAGE(PG8_SB(0, 1), b2 + hstep, voffB);
            PG8_WAIT_V(6); PG8_BAR; PG8_MMA(1, 1, At, B1); PG8_BAR;
            PG8_LDB(B0, 1, 0); PG8_SCHED; PG8_LDA(At, 1, 0); PG8_STAGE(PG8_SA(0, 1), a2 + hstep, voffA);
            PG8_WAIT_L(8); PG8_BAR; PG8_WAIT_L(0); PG8_MMA(0, 0, At, B0); PG8_BAR; PG8_SCHED;
            PG8_LDB(B1, 1, 1); PG8_STAGE(PG8_SB(1, 0), b3, voffB);
            PG8_BAR; PG8_WAIT_L(0); PG8_MMA(0, 1, At, B1); PG8_BAR;
            PG8_LDA(At, 1, 1); PG8_STAGE(PG8_SA(1, 0), a3, voffA);
            PG8_BAR; PG8_WAIT_L(0); PG8_MMA(1, 0, At, B0); PG8_BAR; PG8_SCHED;
            PG8_STAGE(PG8_SB(1, 1), b3 + hstep, voffB);
            PG8_WAIT_V(6); PG8_BAR; PG8_MMA(1, 1, At, B1); PG8_BAR;
            }
        }
        if constexpr (FP8) { asm volatile("s_nop 15\n\ts_nop 15" ::: "memory"); }
        if constexpr (ALIGN_EPI) { if (wr == 0) PG8_BAR; }
        if constexpr (!Epi::AFTER_DRAIN) { E(acc, cur, wr, wc, fr, fq); S.done(cur); }
        if (!has_next) break;
#pragma unroll
        for (int a = 0; a < 2; ++a)
#pragma unroll
            for (int b = 0; b < 2; ++b)
#pragma unroll
                for (int m = 0; m < 4; ++m)
#pragma unroll
                    for (int n = 0; n < 2; ++n) acc[a][b][m][n] = (f32x4){0.f, 0.f, 0.f, 0.f};
        cur = nxt; cA = nA; cB = nB; ++ui;
        if constexpr (ALIGN_EPI) { if (wr == 1) PG8_BAR; }
    }
    PG8_WAIT_V(0);
    if constexpr (!ALIGN_EPI) { if (wr == 0) PG8_BAR; }
    PG8_BAR;
    if constexpr (Epi::AFTER_DRAIN) { E.fused(acc, cur, wr, wc, fr, fq, lds, wid, lane); S.done(cur); }
#undef PG8_SA
#undef PG8_SB
#undef PG8_STAGE
#undef PG8_LDA
#undef PG8_LDB
#undef PG8_MMA
#undef PG8_CAT
#undef PG8_WAIT_V
#undef PG8_WAIT_L
#undef PG8_BAR
#undef PG8_SCHED
}
}
#define LAS __attribute__((address_space(3)))
typedef unsigned short bf16_t;
typedef short bf16x8 __attribute__((ext_vector_type(8)));
typedef float f32x2 __attribute__((ext_vector_type(2)));
typedef float f32x4 __attribute__((ext_vector_type(4)));
typedef float f32x16 __attribute__((ext_vector_type(16)));
typedef unsigned u32x2 __attribute__((ext_vector_type(2)));
typedef unsigned u32x4 __attribute__((ext_vector_type(4)));
constexpr int DM = 2048, SEQ = 2048, NBATCH = 16, MTOK = NBATCH * SEQ, DFF = 5504, NKVH = 20;
constexpr int NQK = 3328;
constexpr int NVT = 1280;
constexpr int LDH = 5568;
constexpr float EPS = 1e-6f;
constexpr float LOG2E = 1.4426950408889634f;
constexpr float QSCALE = 0.125f * LOG2E;
constexpr int NWAVES = 8;
constexpr int LDS_STAGE = 131072, LDS_BYTES = LDS_STAGE + 256;
constexpr size_t MiB = 1u << 20;
constexpr size_t WS_WGU1 = 0, WS_WD1 = 43 * MiB, WS_WIN = WS_WD1 + 22 * MiB, WS_WOUT = WS_WIN + 18 * MiB, WS_WGU2 = WS_WOUT + 8 * MiB, WS_WD2 = WS_WGU2 + 43 * MiB;
constexpr size_t WS_HN = 156 * MiB;
constexpr size_t WS_H = 284 * MiB;
constexpr size_t WS_Q = WS_H, WS_KF = WS_H + 128 * MiB, WS_VF = WS_H + 208 * MiB;
constexpr size_t WS_Y = 636 * MiB;
constexpr size_t WS_SSQ = 764 * MiB;
constexpr size_t WS_CTL = 765 * MiB, CTL_BYTES = 16384;
constexpr size_t WS_X2F8 = 768 * MiB;
constexpr size_t WS_X2B = 832 * MiB;
constexpr size_t WS_END = 960 * MiB;
static_assert(WS_H + (size_t)MTOK * LDH * 2 <= WS_Y, "H fits");
static_assert(WS_WD2 + 22 * MiB <= WS_HN && (size_t)2048 * LDH * 2 <= 22 * MiB, "weights fit");

__device__ __forceinline__ unsigned pk2(float lo, float hi) { unsigned r; asm volatile("v_cvt_pk_bf16_f32 %0, %1, %2" : "=v"(r) : "v"(lo), "v"(hi)); return r; }
__device__ __forceinline__ float bf_lo(unsigned w) { return __uint_as_float(w << 16); }
__device__ __forceinline__ float bf_hi(unsigned w) { return __uint_as_float(w & 0xffff0000u); }
__device__ __forceinline__ float wave_sum(float v) {
#pragma unroll
    for (int o = 1; o < 64; o <<= 1) v += __shfl_xor(v, o);
    return v;
}

__device__ __forceinline__ int dest_row0(int type, int n0) {
    if (type == 0) return n0;
    if (type == 1) return (n0 >> 7) * 256;
    if (type == 2) return (n0 >> 7) * 256 + 128;
    if (n0 < 1024) return n0;
    if (n0 < 1280) return 2048 + (n0 - 1024);
    if (n0 < 1536) return 3328 + (n0 - 1280);
    if (n0 < 2560) return 1024 + (n0 - 1536);
    if (n0 < 3584) return 2304 + (n0 - 2560);
    return n0;
}
__device__ __forceinline__ unsigned pk4_fp8w(float a, float b, float c, float d) {
    a = fminf(fmaxf(a, -448.f), 448.f); b = fminf(fmaxf(b, -448.f), 448.f); c = fminf(fmaxf(c, -448.f), 448.f); d = fminf(fmaxf(d, -448.f), 448.f);
    unsigned w = 0; w = __builtin_amdgcn_cvt_pk_fp8_f32(a, b, w, false); w = __builtin_amdgcn_cvt_pk_fp8_f32(c, d, w, true); return w; }
constexpr float W8_SCALE = 256.f;
template <bool FP8 = false> __device__ __forceinline__ void transpose_item(const float* __restrict__ W, int K, int N, bf16_t* __restrict__ WT, int type, int item, int lane, const float* __restrict__ gk = nullptr, const float* __restrict__ gk2 = nullptr, int ldk = 0, int blk_nt = 0) {
    if (ldk == 0) ldk = K;
    const int nkc = K >> 6, nb = item / nkc, kc = item - nb * nkc, n0 = nb * 128, k0 = kc * 64;
    const int drow = dest_row0(type, n0) + 2 * lane;
    const float* src = W + (size_t)k0 * N + n0 + 2 * lane;
    bf16_t* d0 = WT + (size_t)drow * ldk + k0;
    int img_off1 = 0;
    if (blk_nt) {
        const int rl = drow & 255, pos = (rl & ~31) + pg8::invperm32(rl & 31);
        d0 = WT + (((size_t)(drow >> 8) * blk_nt + kc) * 2 + (pos >> 7)) * 8192; ldk = 0;
        img_off1 = pos & 127; }
#pragma unroll 2
    for (int kb = 0; kb < 8; ++kb) {
        f32x2 v[8];
#pragma unroll
        for (int i = 0; i < 8; ++i) v[i] = *(const f32x2*)(src + (size_t)(kb * 8 + i) * N);
        if (gk) {
            const float* gp = (gk2 && k0 >= 1024) ? gk2 + (k0 - 1024) + kb * 8 : gk + k0 + kb * 8;
#pragma unroll
            for (int i = 0; i < 8; ++i) v[i] *= gp[i];
        }
        if constexpr (FP8) {
            u32x2 a, b;
            a.x = pk4_fp8w(v[0].x * W8_SCALE, v[1].x * W8_SCALE, v[2].x * W8_SCALE, v[3].x * W8_SCALE); a.y = pk4_fp8w(v[4].x * W8_SCALE, v[5].x * W8_SCALE, v[6].x * W8_SCALE, v[7].x * W8_SCALE);
            b.x = pk4_fp8w(v[0].y * W8_SCALE, v[1].y * W8_SCALE, v[2].y * W8_SCALE, v[3].y * W8_SCALE); b.y = pk4_fp8w(v[4].y * W8_SCALE, v[5].y * W8_SCALE, v[6].y * W8_SCALE, v[7].y * W8_SCALE);
            unsigned char* d8 = (unsigned char*)WT + (size_t)drow * ldk + k0 + kb * 8;
            *(u32x2*)d8 = a; *(u32x2*)(d8 + ldk) = b;
            continue;
        }
        u32x4 a, b;
        a.x = pk2(v[0].x, v[1].x); a.y = pk2(v[2].x, v[3].x); a.z = pk2(v[4].x, v[5].x); a.w = pk2(v[6].x, v[7].x);
        b.x = pk2(v[0].y, v[1].y); b.y = pk2(v[2].y, v[3].y); b.z = pk2(v[4].y, v[5].y); b.w = pk2(v[6].y, v[7].y);
        if (blk_nt) { *(u32x4*)(d0 + (pg8::lds_byte(img_off1, kb * 8) >> 1)) = a; *(u32x4*)(d0 + (pg8::lds_byte(img_off1 + 1, kb * 8) >> 1)) = b; }
        else { *(u32x4*)(d0 + kb * 8) = a; *(u32x4*)(d0 + ldk + kb * 8) = b; }
    }
}
__device__ __forceinline__ void rms_row_bf16(const float* xrow, const float* __restrict__ g, bf16_t* orow, int lane) {
    const f32x4* xr = (const f32x4*)xrow + lane;
    f32x4 v[8]; float s = 0.f;
#pragma unroll
    for (int j = 0; j < 8; ++j) { v[j] = xr[64 * j]; s += (v[j].x * v[j].x + v[j].y * v[j].y) + (v[j].z * v[j].z + v[j].w * v[j].w); }
    const float rstd = rsqrtf(wave_sum(s) * (1.f / DM) + EPS);
    u32x2* o8 = (u32x2*)orow + lane;
#pragma unroll
    for (int j = 0; j < 8; ++j) { const f32x4 gv = ((const f32x4*)g)[lane + 64 * j]; u32x2 w; w.x = pk2(v[j].x * rstd * gv.x, v[j].y * rstd * gv.y); w.y = pk2(v[j].z * rstd * gv.z, v[j].w * rstd * gv.w); o8[64 * j] = w; }
}
__device__ __forceinline__ void rms_row_f32(float* xrow, const float* __restrict__ g, int lane) {
    f32x4* xr = (f32x4*)xrow + lane;
    f32x4 v[8]; float s = 0.f;
#pragma unroll
    for (int j = 0; j < 8; ++j) { v[j] = xr[64 * j]; s += (v[j].x * v[j].x + v[j].y * v[j].y) + (v[j].z * v[j].z + v[j].w * v[j].w); }
    const float rstd = rsqrtf(wave_sum(s) * (1.f / DM) + EPS);
#pragma unroll
    for (int j = 0; j < 8; ++j) { const f32x4 gv = ((const f32x4*)g)[lane + 64 * j]; xr[64 * j] = v[j] * rstd * gv; }
}
__device__ __forceinline__ void final_row(const bf16_t* xrow, float ssq, const float* __restrict__ g, float* orow, int lane) {
    const float rstd = rsqrtf(ssq * (1.f / DM) + EPS);
#pragma unroll
    for (int j = 0; j < 4; ++j) { const u32x4 w = ((const u32x4*)xrow)[lane + 64 * j]; const float* gp = g + (lane + 64 * j) * 8; const f32x4 g0 = *(const f32x4*)gp, g1 = *(const f32x4*)(gp + 4);
        f32x4 o0, o1; o0.x = bf_lo(w.x) * rstd * g0.x; o0.y = bf_hi(w.x) * rstd * g0.y; o0.z = bf_lo(w.y) * rstd * g0.z; o0.w = bf_hi(w.y) * rstd * g0.w;
        o1.x = bf_lo(w.z) * rstd * g1.x; o1.y = bf_hi(w.z) * rstd * g1.y; o1.z = bf_lo(w.w) * rstd * g1.z; o1.w = bf_hi(w.w) * rstd * g1.w;
        float* op = orow + (lane + 64 * j) * 8; *(f32x4*)op = o0; *(f32x4*)(op + 4) = o1; }
}
__device__ __forceinline__ void group_norm_row(const bf16_t* yrow, const float* __restrict__ ga, const float* __restrict__ gb, bf16_t* orow, int lane) {
    u32x4 w[4]; float sa = 0.f, sb = 0.f;
#pragma unroll
    for (int j = 0; j < 4; ++j) { w[j] = ((const u32x4*)yrow)[lane + 64 * j]; float s = 0.f;
#pragma unroll
        for (int e = 0; e < 4; ++e) { const float a = bf_lo(w[j][e]), b = bf_hi(w[j][e]); s += a * a + b * b; }
        if (j < 2) sa += s; else sb += s; }
    const float ra = rsqrtf(wave_sum(sa) * (1.f / 1024.f) + EPS), rb = rsqrtf(wave_sum(sb) * (1.f / 1024.f) + EPS);
#pragma unroll
    for (int j = 0; j < 4; ++j) { const float* g = (j < 2 ? ga : gb) + (j & 1) * 512 + lane * 8; const float r = j < 2 ? ra : rb;
        const f32x4 g0 = *(const f32x4*)g, g1 = *(const f32x4*)(g + 4); u32x4 o;
        o.x = pk2(bf_lo(w[j].x) * r * g0.x, bf_hi(w[j].x) * r * g0.y); o.y = pk2(bf_lo(w[j].y) * r * g0.z, bf_hi(w[j].y) * r * g0.w);
        o.z = pk2(bf_lo(w[j].z) * r * g1.x, bf_hi(w[j].z) * r * g1.y); o.w = pk2(bf_lo(w[j].w) * r * g1.z, bf_hi(w[j].w) * r * g1.w);
        ((u32x4*)orow)[lane + 64 * j] = o; }
}

__device__ __forceinline__ int crow(int r, int hi) { return (r & 3) + 8 * (r >> 2) + 4 * hi; }
#define MFMA32(a, b, c) __builtin_amdgcn_mfma_f32_32x32x16_bf16((a), (b), (c), 0, 0, 0)
__device__ __forceinline__ void load_k(bf16x8 (&kf)[8], const bf16_t* __restrict__ Kb, int a, int lane) {
#pragma unroll
    for (int blk = 0; blk < 2; ++blk)
#pragma unroll
        for (int d0 = 0; d0 < 4; ++d0) kf[blk * 4 + d0] = *(const bf16x8*)(Kb + (size_t)(2 * a + blk) * 2048 + d0 * 512 + lane * 8);
}
__device__ __forceinline__ void load_v(bf16x8 (&vf)[8], const bf16_t* __restrict__ Vb, int a, int lane) {
#pragma unroll
    for (int g4 = 0; g4 < 4; ++g4)
#pragma unroll
        for (int d0 = 0; d0 < 2; ++d0) vf[g4 * 2 + d0] = *(const bf16x8*)(Vb + (size_t)((4 * a + g4) * 2 + d0) * 512 + lane * 8);
}
__device__ __forceinline__ bf16x8 pack8(const float (&A)[32], int base) {
    u32x4 w; w.x = pk2(A[base], A[base + 1]); w.y = pk2(A[base + 2], A[base + 3]); w.z = pk2(A[base + 4], A[base + 5]); w.w = pk2(A[base + 6], A[base + 7]);
    return __builtin_bit_cast(bf16x8, w);
}
__device__ __forceinline__ void pv_acc(f32x16 (&o)[2], const float (&A)[32], const bf16x8 (&vf)[8]) {
#pragma unroll
    for (int g4 = 0; g4 < 4; ++g4) { const bf16x8 pa = pack8(A, 8 * g4); o[0] = MFMA32(pa, vf[g4 * 2], o[0]); o[1] = MFMA32(pa, vf[g4 * 2 + 1], o[1]); }
}
__device__ __forceinline__ void qk_tile(float (&z)[32], const bf16x8 (&kf)[8], const bf16x8 (&qr)[4]) {
    f32x16 p0 = {}, p1 = {};
#pragma unroll
    for (int d0 = 0; d0 < 4; ++d0) { p0 = MFMA32(kf[d0], qr[d0], p0); p1 = MFMA32(kf[4 + d0], qr[d0], p1); }
#pragma unroll
    for (int r = 0; r < 16; ++r) { z[r] = p0[r]; z[16 + r] = p1[r]; }
}
template <int BLK> __device__ __forceinline__ void sb_block(f32x16 (&o)[2], float& carry, const f32x16& p, const bf16x8 (&vf)[8], int a, bool diag, int qpos, int hi) {
    float u[16], be[16];
#pragma unroll
    for (int i = 0; i < 16; ++i) { const float e = __builtin_amdgcn_exp2f(fminf(p[i], 126.f)); const float uu = __builtin_amdgcn_rcpf(1.0f + e); u[i] = uu; be[i] = e * uu; }
    if (diag) {
#pragma unroll
        for (int i = 0; i < 16; ++i) { const int key = 64 * a + 32 * BLK + crow(i, hi); if (key >= qpos) { u[i] = 1.f; be[i] = 0.f; } }
    }
    float X[16], T[4], oth[4], PS[4], SS[4];
#pragma unroll
    for (int k = 0; k < 4; ++k) { const float x2 = u[4 * k + 3], x1 = x2 * u[4 * k + 2], x0 = x1 * u[4 * k + 1]; X[4 * k + 3] = 1.f; X[4 * k + 2] = x2; X[4 * k + 1] = x1; X[4 * k] = x0; T[k] = x0 * u[4 * k]; }
#pragma unroll
    for (int k = 0; k < 4; ++k) { oth[k] = __shfl_xor(T[k], 32); PS[k] = T[k] * oth[k]; }
    SS[3] = carry;
#pragma unroll
    for (int k = 2; k >= 0; --k) SS[k] = SS[k + 1] * PS[k + 1];
    carry = SS[0] * PS[0];
    float A[16];
#pragma unroll
    for (int k = 0; k < 4; ++k) { const float R = hi ? SS[k] : SS[k] * oth[k];
        A[4 * k + 3] = be[4 * k + 3] * R; A[4 * k + 2] = be[4 * k + 2] * (X[4 * k + 2] * R); A[4 * k + 1] = be[4 * k + 1] * (X[4 * k + 1] * R); A[4 * k] = be[4 * k] * (X[4 * k] * R); }
#pragma unroll
    for (int j = 0; j < 2; ++j) { u32x4 w; w.x = pk2(A[8 * j], A[8 * j + 1]); w.y = pk2(A[8 * j + 2], A[8 * j + 3]); w.z = pk2(A[8 * j + 4], A[8 * j + 5]); w.w = pk2(A[8 * j + 6], A[8 * j + 7]);
        const bf16x8 pa = __builtin_bit_cast(bf16x8, w); o[0] = MFMA32(pa, vf[(2 * BLK + j) * 2], o[0]); o[1] = MFMA32(pa, vf[(2 * BLK + j) * 2 + 1], o[1]); }
}
__device__ __forceinline__ void sb_tile(f32x16 (&o)[2], float& carry, const bf16x8 (&kf)[8], const bf16x8 (&vf)[8], const bf16x8 (&qr)[4], int a, bool diag, int qpos, int hi) {
    f32x16 p0 = {}, p1 = {};
#pragma unroll
    for (int d0 = 0; d0 < 4; ++d0) { p1 = MFMA32(kf[4 + d0], qr[d0], p1); p0 = MFMA32(kf[d0], qr[d0], p0); }
    sb_block<1>(o, carry, p1, vf, a, diag, qpos, hi);
    sb_block<0>(o, carry, p0, vf, a, diag, qpos, hi);
}
__device__ __forceinline__ void store_o(const f32x16 (&o)[2], bf16_t* Yp  , float* ssqp  , LAS unsigned char* stg, int lane) {
    const int dl = lane & 31, hi = lane >> 5;
    LAS bf16_t* st = (LAS bf16_t*)stg;
#pragma unroll
    for (int d0 = 0; d0 < 2; ++d0)
#pragma unroll
        for (int r = 0; r < 16; ++r) { const unsigned w = pk2(o[d0][r], 0.f); st[crow(r, hi) * 64 + d0 * 32 + dl] = (bf16_t)(w & 0xffffu); }
    asm volatile("s_waitcnt lgkmcnt(0)" ::: "memory");
#pragma unroll
    for (int i = 0; i < 4; ++i) { const int row = i * 8 + (lane >> 3), ch = lane & 7; const u32x4 v = *(const LAS u32x4*)(st + row * 64 + ch * 8); *(u32x4*)(Yp + (size_t)row * 2048 + ch * 8) = v;
        float s = 0.f;
#pragma unroll
        for (int e = 0; e < 4; ++e) { const float a = bf_lo(v[e]), b = bf_hi(v[e]); s += a * a + b * b; }
        s += __shfl_xor(s, 1); s += __shfl_xor(s, 2); s += __shfl_xor(s, 4);
        if (ch == 0) __hip_atomic_fetch_add(ssqp + 2 * row, s, __ATOMIC_RELAXED, __HIP_MEMORY_SCOPE_AGENT); }
    asm volatile("s_waitcnt lgkmcnt(0)" ::: "memory");
}
__device__ __forceinline__ void load_kb(bf16x8 (&kf)[4], const bf16_t* __restrict__ Kb, int kb, int lane) {
#pragma unroll
    for (int d0 = 0; d0 < 4; ++d0) kf[d0] = *(const bf16x8*)(Kb + (size_t)kb * 2048 + d0 * 512 + lane * 8);
}
__device__ __forceinline__ void load_vb(bf16x8 (&vf)[4], const bf16_t* __restrict__ Vb, int kb, int lane) {
#pragma unroll
    for (int j = 0; j < 2; ++j)
#pragma unroll
        for (int d0 = 0; d0 < 2; ++d0) vf[j * 2 + d0] = *(const bf16x8*)(Vb + (size_t)((2 * kb + j) * 2 + d0) * 512 + lane * 8);
}
__device__ __forceinline__ void pv_block(f32x16 (&o)[2], const f32x16& p, const bf16x8 (&vf)[4]) {
#pragma unroll
    for (int j = 0; j < 2; ++j) { u32x4 w; w.x = pk2(p[8 * j], p[8 * j + 1]); w.y = pk2(p[8 * j + 2], p[8 * j + 3]); w.z = pk2(p[8 * j + 4], p[8 * j + 5]); w.w = pk2(p[8 * j + 6], p[8 * j + 7]);
        const bf16x8 pa = __builtin_bit_cast(bf16x8, w); o[0] = MFMA32(pa, vf[j * 2], o[0]); o[1] = MFMA32(pa, vf[j * 2 + 1], o[1]); }
}
__device__ __forceinline__ void sb_item(int b, int h, int c, const bf16_t* __restrict__ Q, const bf16_t* __restrict__ KF, const bf16_t* __restrict__ VF, bf16_t* Y, float* ssqy, LAS unsigned char* stg, int lane) {
    const int r32 = lane & 31, hi = lane >> 5, q0 = 32 * c, qpos = q0 + r32;
    const bf16_t* Qrow = Q + (size_t)(b * SEQ + qpos) * 2048 + 1024 + h * 64;
    bf16x8 qr[4];
#pragma unroll
    for (int d0 = 0; d0 < 4; ++d0) qr[d0] = *(const bf16x8*)(Qrow + d0 * 16 + hi * 8);
    const bf16_t* Kb = KF + (size_t)(b * NKVH + 4 + h) * 131072; const bf16_t* Vb = VF + (size_t)(b * NKVH + 4 + h) * 131072;
    f32x16 o[2]; o[0] = f32x16{}; o[1] = f32x16{};
    float carry = 1.f;
    bf16x8 kc[4], kn[4], vc[4], vn[4];
    int kb = c;
    load_kb(kc, Kb, kb, lane); load_vb(vc, Vb, kb, lane);
#pragma unroll 1
    for (;;) {
        const int kp = kb > 0 ? kb - 1 : 0;
        load_kb(kn, Kb, kp, lane); load_vb(vn, Vb, kp, lane);
        f32x16 p = {};
#pragma unroll
        for (int d0 = 0; d0 < 4; ++d0) p = MFMA32(kc[d0], qr[d0], p);
        float u[16], be[16];
#pragma unroll
        for (int i = 0; i < 16; ++i) { const float e = __builtin_amdgcn_exp2f(fminf(p[i], 126.f)); const float uu = __builtin_amdgcn_rcpf(1.0f + e); u[i] = uu; be[i] = e * uu; }
        if (kb == c) {
#pragma unroll
            for (int i = 0; i < 16; ++i) { if (crow(i, hi) >= r32) { u[i] = 1.f; be[i] = 0.f; } }
        }
        float X[16], T[4], oth[4], PS[4], SS[4];
#pragma unroll
        for (int k = 0; k < 4; ++k) { const float x2 = u[4 * k + 3], x1 = x2 * u[4 * k + 2], x0 = x1 * u[4 * k + 1]; X[4 * k + 3] = 1.f; X[4 * k + 2] = x2; X[4 * k + 1] = x1; X[4 * k] = x0; T[k] = x0 * u[4 * k]; }
#pragma unroll
        for (int k = 0; k < 4; ++k) { oth[k] = __shfl_xor(T[k], 32); PS[k] = T[k] * oth[k]; }
        SS[3] = carry;
#pragma unroll
        for (int k = 2; k >= 0; --k) SS[k] = SS[k + 1] * PS[k + 1];
        carry = SS[0] * PS[0];
#pragma unroll
        for (int k = 0; k < 4; ++k) { const float R = hi ? SS[k] : SS[k] * oth[k];
            p[4 * k + 3] = be[4 * k + 3] * R; p[4 * k + 2] = be[4 * k + 2] * (X[4 * k + 2] * R); p[4 * k + 1] = be[4 * k + 1] * (X[4 * k + 1] * R); p[4 * k] = be[4 * k] * (X[4 * k] * R); }
        pv_block(o, p, vc);
        if (kb == 0) break;
        if (__all(carry < 1.17549435e-38f)) break;
        --kb;
#pragma unroll
        for (int i = 0; i < 4; ++i) { kc[i] = kn[i]; vc[i] = vn[i]; }
    }
    store_o(o, Y + (size_t)(b * SEQ + q0) * 2048 + 1024 + h * 64, ssqy + (size_t)(b * SEQ + q0) * 2 + 1, stg, lane);
}
__device__ __forceinline__ void swa_item(int b, int h, int c, const bf16_t* __restrict__ Q, const bf16_t* __restrict__ KF, const bf16_t* __restrict__ VF, bf16_t* Y, float* ssqy, float sink2, float slope2, LAS unsigned char* stg, int lane) {
    const int r32 = lane & 31, hi = lane >> 5, q0 = 32 * c, qpos = q0 + r32, kv = h >> 2;
    const bf16_t* Qrow = Q + (size_t)(b * SEQ + qpos) * 2048 + h * 64;
    bf16x8 qr[4];
#pragma unroll
    for (int d0 = 0; d0 < 4; ++d0) qr[d0] = *(const bf16x8*)(Qrow + d0 * 16 + hi * 8);
    const bf16_t* Kb = KF + (size_t)(b * NKVH + kv) * 131072; const bf16_t* Vb = VF + (size_t)(b * NKVH + kv) * 131072;
    f32x16 o[2]; o[0] = f32x16{}; o[1] = f32x16{};
    float m = sink2, l = hi ? 0.f : 1.f;
    const int klo = c >= 4 ? c - 4 : 0;
    bf16x8 kc[4], kn[4], vc[4], vn[4];
    int kb = c;
    load_kb(kc, Kb, kb, lane); load_vb(vc, Vb, kb, lane);
#pragma unroll 1
    for (;;) {
        const int kp = kb > klo ? kb - 1 : klo;
        load_kb(kn, Kb, kp, lane); load_vb(vn, Vb, kp, lane);
        f32x16 p = {};
#pragma unroll
        for (int d0 = 0; d0 < 4; ++d0) p = MFMA32(kc[d0], qr[d0], p);
        const float dbase = (float)(qpos - 32 * kb - 4 * hi), sbase = slope2 * dbase;
#pragma unroll
        for (int r = 0; r < 16; ++r) p[r] = __builtin_fmaf(slope2, (float)((r & 3) + 8 * (r >> 2)), p[r]) - sbase;
        if (kb == c) {
#pragma unroll
            for (int r = 0; r < 16; ++r) p[r] = ((float)((r & 3) + 8 * (r >> 2)) <= dbase) ? p[r] : -INFINITY;
        } else if (kb + 4 == c) {
            const float dlim = dbase - 128.f;
#pragma unroll
            for (int r = 0; r < 16; ++r) p[r] = ((float)((r & 3) + 8 * (r >> 2)) > dlim) ? p[r] : -INFINITY;
        }
        float r0 = fmaxf(p[0], p[1]), r1 = fmaxf(p[2], p[3]);
#pragma unroll
        for (int r = 4; r < 16; r += 4) { r0 = fmaxf(r0, fmaxf(p[r], p[r + 1])); r1 = fmaxf(r1, fmaxf(p[r + 2], p[r + 3])); }
        float rm = fmaxf(r0, r1);
        rm = fmaxf(rm, __shfl_xor(rm, 32));
        if (__any(rm > m)) {
            const float mn = fmaxf(m, rm), f = __builtin_amdgcn_exp2f(m - mn); m = mn; l *= f;
#pragma unroll
            for (int r = 0; r < 16; ++r) { const float fr_ = __shfl(f, crow(r, hi)); o[0][r] *= fr_; o[1][r] *= fr_; }
        }
        float l0 = 0.f, l1 = 0.f;
#pragma unroll
        for (int r = 0; r < 16; r += 2) { p[r] = __builtin_amdgcn_exp2f(p[r] - m); p[r + 1] = __builtin_amdgcn_exp2f(p[r + 1] - m); l0 += p[r]; l1 += p[r + 1]; }
        l += l0 + l1;
        pv_block(o, p, vc);
        if (kb == klo) break;
        --kb;
#pragma unroll
        for (int i = 0; i < 4; ++i) { kc[i] = kn[i]; vc[i] = vn[i]; }
    }
    l += __shfl_xor(l, 32);
    const float inv = 1.0f / l;
#pragma unroll
    for (int r = 0; r < 16; ++r) { const float ir = __shfl(inv, crow(r, hi)); o[0][r] *= ir; o[1][r] *= ir; }
    store_o(o, Y + (size_t)(b * SEQ + q0) * 2048 + h * 64, ssqy + (size_t)(b * SEQ + q0) * 2, stg, lane);
}

#define XB_TMO      128
#define XB_XCNT(j)  (256  + 64 * (j))
#define XB_XSUB(j)  (1280 + 64 * (j))
#define XB_XGEN(j)  (2304 + 64 * (j))
#define XB_TOP      3328
#define XB_TOPGEN   3392
#define XCD_BAR_WORDS 3456
#define XB_SPIN_CAP (1u << 18)

__device__ __forceinline__ unsigned xb_ld(unsigned* p)              { return __hip_atomic_load(p, __ATOMIC_RELAXED, __HIP_MEMORY_SCOPE_AGENT); }
__device__ __forceinline__ unsigned xb_add(unsigned* p, unsigned v) { return __hip_atomic_fetch_add(p, v, __ATOMIC_RELAXED, __HIP_MEMORY_SCOPE_AGENT); }
__device__ __forceinline__ unsigned xb_xcc_id() { return (unsigned)__builtin_amdgcn_s_getreg((3 << 11) | 20) & 0xFu; }
#define XB_SPIN(cond, bar) do { unsigned _sp = 0; while (cond) { __builtin_amdgcn_s_sleep(1); \
    if ((++_sp & 255u) == 0u) { if (xb_ld(&(bar)[XB_TMO])) break; if (_sp > XB_SPIN_CAP) { atomicAdd(&(bar)[XB_TMO], 1u); break; } } } } while (0)

struct XcdBarrier {
    unsigned* bar; unsigned x;
    volatile LAS unsigned* st;
};

__device__ __forceinline__ XcdBarrier xcd_barrier_post(unsigned* bar, volatile LAS unsigned* st, const bool t0  ) {
    XcdBarrier b; b.bar = bar; b.x = xb_xcc_id(); b.st = st;
    if (t0) (void)xb_add(&bar[XB_XCNT(b.x)], 1u);
    return b;
}
__device__ __forceinline__ void xcd_barrier_complete(unsigned* bar, unsigned x, unsigned& nloc, unsigned& nx) {
    const unsigned G = gridDim.x * gridDim.y * gridDim.z;
    unsigned sum, cnt, mine, sp = 0u;
    for (;;) {
        sum = 0u; cnt = 0u; mine = 0u;
#pragma unroll
        for (unsigned j = 0; j < 16; ++j) { const unsigned c = xb_ld(&bar[XB_XCNT(j)]); sum += c; cnt += (c > 0u) ? 1u : 0u; mine = (j == x) ? c : mine; }
        if (sum == G) break;
        __builtin_amdgcn_s_sleep(1);
        if ((++sp & 255u) == 0u) { if (xb_ld(&bar[XB_TMO])) break; if (sp > XB_SPIN_CAP) { atomicAdd(&bar[XB_TMO], 1u); break; } }
    }
    nloc = mine > 0u ? mine : 1u; nx = cnt > 0u ? cnt : 1u;
}

__device__ __forceinline__ void xcd_barrier(const XcdBarrier& b, const bool t0  ) {
    asm volatile("s_waitcnt vmcnt(0)" ::: "memory");
    __syncthreads();
    if (t0) {
        unsigned* bar = b.bar;
        __builtin_amdgcn_s_waitcnt(0);
        unsigned nloc = b.st[0], nx = b.st[1];
        if (nloc == 0u) { xcd_barrier_complete(bar, b.x, nloc, nx); b.st[0] = nloc; b.st[1] = nx; }
        const unsigned old = xb_add(&bar[XB_XSUB(b.x)], 1u);
        const unsigned gen = old / nloc;
        if (old + 1u == (gen + 1u) * nloc) {
            __builtin_amdgcn_fence(__ATOMIC_RELEASE, "agent");
            asm volatile("s_waitcnt vmcnt(0)" ::: "memory");
            const unsigned og = xb_add(&bar[XB_TOP], 1u);
            const unsigned tg = og / nx;
            if (og + 1u == (tg + 1u) * nx) xb_add(&bar[XB_TOPGEN], 1u);
            else XB_SPIN(xb_ld(&bar[XB_TOPGEN]) == tg, bar);
            __builtin_amdgcn_fence(__ATOMIC_ACQUIRE, "agent");
            xb_add(&bar[XB_XGEN(b.x)], 1u);
            asm volatile("s_waitcnt vmcnt(0)" ::: "memory");
        } else {
            XB_SPIN(xb_ld(&bar[XB_XGEN(b.x)]) == gen, bar);
            __builtin_amdgcn_fence(__ATOMIC_ACQUIRE, "agent");
            asm volatile("s_waitcnt vmcnt(0)" ::: "memory");
        }
    }
    __syncthreads();
}

__device__ __forceinline__ int fresh_lane() { return pg8::lane_id(); }
struct Args { const float* in[16]; float* out; unsigned char* ws; };
__global__ void __launch_bounds__(NWAVES * 64, 2) hybrid_fwd(Args args) {
    extern __shared__ __attribute__((aligned(16))) unsigned char lds_raw[];
    LAS unsigned char* lds = (LAS unsigned char*)lds_raw;
    cg::grid_group grid = cg::this_grid();
    const int wave = __builtin_amdgcn_readfirstlane((int)threadIdx.x >> 6);
#define T0() (wave == 0 && pg8::lane_id() == 0)
    volatile LAS unsigned* bst = (volatile LAS unsigned*)(lds + LDS_STAGE);
    if (wave == 0) { const int l_ = pg8::lane_id(); if (l_ < 2) bst[l_] = 0u; }
    __syncthreads();
    const XcdBarrier xbar = xcd_barrier_post((unsigned*)(args.ws + WS_CTL), bst, T0());
    const int G = gridDim.x, gw = blockIdx.x * NWAVES + wave, NGW = G * NWAVES;
    unsigned char* ws = args.ws;
    const float* x = args.in[0];
    float* out = args.out;
    bf16_t* WGU1 = (bf16_t*)(ws + WS_WGU1); bf16_t* WD1 = (bf16_t*)(ws + WS_WD1); bf16_t* WIN = (bf16_t*)(ws + WS_WIN); bf16_t* WOUT = (bf16_t*)(ws + WS_WOUT);
    bf16_t* WGU2 = (bf16_t*)(ws + WS_WGU2); bf16_t* WD2 = (bf16_t*)(ws + WS_WD2);
    bf16_t* HN = (bf16_t*)(ws + WS_HN); bf16_t* HB = (bf16_t*)(ws + WS_H); bf16_t* QB = (bf16_t*)(ws + WS_Q); bf16_t* KF = (bf16_t*)(ws + WS_KF); bf16_t* VF = (bf16_t*)(ws + WS_VF);
    bf16_t* YB = (bf16_t*)(ws + WS_Y);
    float* ssq1 = (float*)(ws + WS_SSQ); float* ssq2 = ssq1 + MTOK; float* ssqy = ssq2 + MTOK; float* ssq3 = ssqy + 2 * MTOK;
    unsigned char* X2F8 = ws + WS_X2F8; bf16_t* X2B = (bf16_t*)(ws + WS_X2B);

    {
        const int lane = pg8::lane_id(), tid = wave * 64 + lane;
        constexpr int I_GU = 43 * 32, I_DN = 16 * 86, I_IN = 36 * 32, I_OUT = 16 * 32;
        constexpr int NITEMS = 4 * I_GU + 2 * I_DN + I_IN + I_OUT;
        for (int it = gw; it < NITEMS; it += NGW) {
            int r = it;
            if (r < I_GU) { transpose_item(args.in[2], DM, DFF, WGU1, 1, r, lane); continue; } r -= I_GU;
            if (r < I_GU) { transpose_item(args.in[3], DM, DFF, WGU1, 2, r, lane); continue; } r -= I_GU;
            if (r < I_DN) { transpose_item(args.in[4], DFF, DM, WD1, 0, r, lane, nullptr, nullptr, 0, DFF / 64); continue; } r -= I_DN;
            if (r < I_IN) { transpose_item(args.in[6], DM, 4608, WIN, 3, r, lane, args.in[5]); continue; } r -= I_IN;
            if (r < I_OUT) { transpose_item(args.in[10], DM, DM, WOUT, 0, r, lane, args.in[8], args.in[9]); continue; } r -= I_OUT;
            if (r < I_GU) { transpose_item<true>(args.in[12], DM, DFF, WGU2, 1, r, lane, args.in[11]); continue; } r -= I_GU;
            if (r < I_GU) { transpose_item<true>(args.in[13], DM, DFF, WGU2, 2, r, lane, args.in[11]); continue; } r -= I_GU;
            transpose_item(args.in[14], DFF, DM, WD2, 0, r, lane, nullptr, nullptr, 0, DFF / 64);
        }
        for (int m = gw; m < MTOK; m += NGW) rms_row_bf16(x + (size_t)m * DM, args.in[1], HN + (size_t)m * DM, lane);
        for (int i = blockIdx.x * (NWAVES * 64) + tid; i < 5 * MTOK; i += G * NWAVES * 64) ssq1[i] = 0.f;
    }
    if (args.ws == nullptr) grid.sync();
    xcd_barrier(xbar, T0());
    {
        pg8::Gemm g{HN, WGU1, MTOK, 2 * DFF, DM, DM, 0}; pg8::StaticOrder S; S.init(MTOK, 2 * DFF, G, (int)blockIdx.x);
        pg8::EpiSwiglu E{HB, LDH, nullptr, 1.0f, DFF / 64};
        pg8::gemm_phase<pg8::EpiSwiglu, pg8::StaticOrder, true, true>(lds, g, S, E, wave);
    }
    xcd_barrier(xbar, T0());
    {
        pg8::Gemm g{HB, WD1, MTOK, DM, DFF, LDH, 2}; pg8::StaticOrder S; S.init(MTOK, DM, G, (int)blockIdx.x, 1);
        pg8::EpiResidStat<false, false, false, true, false> E{x, nullptr, HN, nullptr, ssq1, 0.5f, nullptr};
        pg8::gemm_phase<pg8::EpiResidStat<false, false, false, true, false>, pg8::StaticOrder, true, true>(lds, g, S, E, wave);
    }
    xcd_barrier(xbar, T0());
    {
        pg8::Gemm g{HN, WIN, MTOK, NQK, DM, DM, 0}; pg8::InProjOrder S; S.init(MTOK, NQK, NVT, G, (int)blockIdx.x, HN, WIN, DM);
        pg8::EpiInProj E{pg8::EpiQK{QB, KF, QSCALE, ssq1}, pg8::EpiVT{VF, ssq1}};
        pg8::gemm_phase<pg8::EpiInProj, pg8::InProjOrder, true, true>(lds, g, S, E, wave);
    }
    xcd_barrier(xbar, T0());
    { const int lane5 = fresh_lane();
    for (int pi = gw; pi < NBATCH * 16 * 8; pi += NGW) {
        const int bh = pi >> 3, s = pi & 7, b = bh >> 4, h = bh & 15;
#pragma unroll 1
        for (int i = 0; i < 8; ++i) { const int c = 16 * (i >> 1) + ((i & 1) ? 15 - s : s); sb_item(b, h, c, QB, KF, VF, YB, ssqy, lds + wave * 4096, lane5); }
        const float sink2 = args.in[7][h] * LOG2E, slope2 = __builtin_amdgcn_exp2f(-0.5f * (float)(h + 1)) * LOG2E;
#pragma unroll 1
        for (int i = 0; i < 8; ++i) { const int c = 16 * (i >> 1) + ((i & 1) ? 15 - s : s); swa_item(b, h, c, QB, KF, VF, YB, ssqy, sink2, slope2, lds + wave * 4096, lane5); }
    }
    }
    xcd_barrier(xbar, T0());
    {
        pg8::Gemm g{YB, WOUT, MTOK, DM, DM, DM, 0}; pg8::StaticOrder S; S.init(MTOK, DM, G, (int)blockIdx.x);
        pg8::EpiResidStat<true, true, false, true, true> E{HN, nullptr, X2B, X2F8, ssq2, 1.0f, ssqy};
        pg8::gemm_phase<pg8::EpiResidStat<true, true, false, true, true>, pg8::StaticOrder, true, true>(lds, g, S, E, wave);
    }
    xcd_barrier(xbar, T0());
    {
        pg8::Gemm g{(const bf16_t*)X2F8, WGU2, MTOK, 2 * DFF, DM / 2, DM / 2, 0}; pg8::StaticOrder S; S.init(MTOK, 2 * DFF, G, (int)blockIdx.x);
        pg8::EpiSwiglu E{HB, LDH, ssq2, 1.0f / W8_SCALE, DFF / 64};
        pg8::gemm_phase<pg8::EpiSwiglu, pg8::StaticOrder, true, true, true>(lds, g, S, E, wave);
    }
    xcd_barrier(xbar, T0());
    {
        pg8::Gemm g{HB, WD2, MTOK, DM, DFF, LDH, 2}; pg8::StaticOrder S; S.init(MTOK, DM, G, (int)blockIdx.x, 1);
        pg8::EpiResidStat<false, true, false, true, false> E{X2B, nullptr, HN, nullptr, ssq3, 0.5f, nullptr};
        pg8::gemm_phase<pg8::EpiResidStat<false, true, false, true, false>, pg8::StaticOrder, true, true>(lds, g, S, E, wave);
    }
    xcd_barrier(xbar, T0());
    { const int lane11 = fresh_lane();
    for (int m = gw; m < MTOK; m += NGW) final_row(HN + (size_t)m * DM, ssq3[m], args.in[15], out + (size_t)m * DM, lane11); }
}

extern "C" void kernel_launch(void* const* d_in, const int* in_sizes, int n_in, void* d_out, int out_size, void* d_ws, size_t ws_size, hipStream_t stream) {
    static int grid_blocks = 0;
    if (grid_blocks == 0) {
        if (n_in != 16 || in_sizes[0] != MTOK * DM || out_size != MTOK * DM || ws_size < WS_END) {
            fprintf(stderr, "kernel_launch: unexpected shapes (n_in %d in0 %d out %d ws %zu)\n", n_in, n_in > 0 ? in_sizes[0] : -1, out_size, ws_size); grid_blocks = -1; return; }
        int dev = 0, cus = 0, per_cu = 0;
        hipGetDevice(&dev);
        hipDeviceGetAttribute(&cus, hipDeviceAttributeMultiprocessorCount, dev);
        hipFuncSetAttribute((const void*)hybrid_fwd, hipFuncAttributeMaxDynamicSharedMemorySize, LDS_BYTES);
        hipOccupancyMaxActiveBlocksPerMultiprocessor(&per_cu, (const void*)hybrid_fwd, NWAVES * 64, LDS_BYTES);
        if (per_cu < 1) { fprintf(stderr, "kernel_launch: occupancy query says %d blocks/CU\n", per_cu); per_cu = 1; }
        grid_blocks = cus * per_cu;
    }
    if (grid_blocks < 0) return;
    if (hipMemsetAsync((char*)d_ws + WS_CTL, 0, CTL_BYTES, stream) != hipSuccess) { fprintf(stderr, "kernel_launch: hipMemsetAsync failed\n"); return; }
    Args a{};
    for (int i = 0; i < 16; ++i) a.in[i] = (const float*)d_in[i];
    a.out = (float*)d_out; a.ws = (unsigned char*)d_ws;
    void* kargs[] = {&a};
    hipError_t e = hipLaunchCooperativeKernel((const void*)hybrid_fwd, dim3(grid_blocks), dim3(NWAVES * 64), kargs, LDS_BYTES, stream);
    if (e != hipSuccess) fprintf(stderr, "cooperative launch failed: %s (grid %d)\n", hipGetErrorString(e), grid_blocks);
}
```

```cpp
#include <hip/hip_runtime.h>
#include <hip/hip_cooperative_groups.h>
#include <cstdio>
#include <cstdint>
#include <type_traits>
namespace cg = cooperative_groups;
namespace pg8 {
#define PG8_LAS __attribute__((address_space(3)))
typedef unsigned short bf16_t;
typedef short bf16x8 __attribute__((ext_vector_type(8)));
typedef float f32x4 __attribute__((ext_vector_type(4)));
typedef unsigned u32x4 __attribute__((ext_vector_type(4)));
typedef int i32x4 __attribute__((ext_vector_type(4)));
typedef int i32x8 __attribute__((ext_vector_type(8)));
__device__ __forceinline__ int lane_id() { int l; asm volatile("v_mbcnt_lo_u32_b32 %0, -1, 0\n\tv_mbcnt_hi_u32_b32 %0, -1, %0" : "=v"(l)); return l; }
constexpr int BM = 256, BK = 64, HALF = 128, HTB = HALF * BK * 2  , STAGE_BYTES = 8 * HTB, NXCD = 8, WGM = 8;

__host__ __device__ __forceinline__ int lds_byte(int r, int c) { const int st = (r >> 4) * 2 + (c >> 5), rr = r & 15, cc = c & 31, ob = rr * 64 + cc * 2; return st * 1024 + (ob ^ (((ob >> 9) & 1) << 5)); }
__host__ __device__ __forceinline__ void stage_rc(int b, int& R, int& C) { const int st = b / 1024, sb = b % 1024, swz = sb ^ (((sb >> 9) & 1) << 5); R = (st >> 1) * 16 + swz / 64; C = (st & 1) * 32 + (swz % 64) / 2; }
__host__ __device__ __forceinline__ int perm32(int rho) { const int n = rho >> 4, i = rho & 15; return 8 * (i >> 2) + 4 * n + (i & 3); }

struct Unit { int pm, pn, ty; };
__host__ __device__ __forceinline__ int invperm32(int s) { return 16 * ((s >> 2) & 1) + 4 * (s >> 3) + (s & 3); }
struct Gemm { const bf16_t* A; const bf16_t* Bt; int M, N, K, ld, blk; };

struct StaticOrder {
    int nM, nN, nwg, G, c, rev;
    __host__ __device__ void init(int M, int N, int G_, int c_, int rev_ = 0) { nM = M / BM; nN = N / BM; nwg = nM * nN; G = G_; c = c_; rev = rev_; }
    __host__ __device__ bool next(int i, Unit& u) const {
        const long L = (long)i * G + c; if (L >= nwg) return false;
        u.ty = 0; map((int)L, u); return true;
    }
    __host__ __device__ void map(int L, Unit& u) const {
        int wgid = L; { const int q = nwg / NXCD, r = nwg % NXCD, xcd = wgid % NXCD, off = wgid / NXCD; wgid = (xcd < r ? xcd * (q + 1) : r * (q + 1) + (xcd - r) * q) + off; }
        const int nig = WGM * nN, gid = wgid / nig, fm = gid * WGM, gsz = (nM - fm) < WGM ? (nM - fm) : WGM;
        u.pm = fm + ((wgid % nig) % gsz); u.pn = (wgid % nig) / gsz; if (rev) u.pm = nM - 1 - u.pm;
    }
    __device__ __forceinline__ const char* pa(const Gemm& g, const Unit& u, size_t tstep) const { return (const char*)g.A + (size_t)u.pm * tstep; }
    __device__ __forceinline__ const char* pb(const Gemm& g, const Unit& u, size_t tstep) const { return (const char*)g.Bt + (size_t)u.pn * tstep; }
    __device__ __forceinline__ void a_ready(const Unit&) const {}
    __device__ __forceinline__ void done(const Unit&) const {}
};

__device__ __forceinline__ unsigned cvt_pk_bf16(float lo, float hi) { unsigned r; asm volatile("v_cvt_pk_bf16_f32 %0, %1, %2" : "=v"(r) : "v"(lo), "v"(hi)); return r; }
typedef float f32x2 __attribute__((ext_vector_type(2)));
typedef unsigned u32x2 __attribute__((ext_vector_type(2)));
typedef float f32x2 __attribute__((ext_vector_type(2)));
__device__ __forceinline__ unsigned pk4_fp8(float a, float b, float c, float d) {
    a = fminf(fmaxf(a, -448.f), 448.f); b = fminf(fmaxf(b, -448.f), 448.f); c = fminf(fmaxf(c, -448.f), 448.f); d = fminf(fmaxf(d, -448.f), 448.f);
    unsigned w = 0; w = __builtin_amdgcn_cvt_pk_fp8_f32(a, b, w, false); w = __builtin_amdgcn_cvt_pk_fp8_f32(c, d, w, true); return w; }
__device__ __forceinline__ float silu_mul(float g, float u) { return g * __builtin_amdgcn_rcpf(1.0f + __builtin_amdgcn_exp2f(-1.4426950408889634f * g)) * u; }

struct EpiSwiglu {
    static constexpr bool PERM = true, AFTER_DRAIN = false, MIDHOOK = false;
    bf16_t* O; int ldc; const float* ssq; float oscale; int nt_blk;
    __device__ __forceinline__ void operator()(const f32x4 (&acc)[2][2][4][2], const Unit& u, int wr, int wc, int fr, int fq) const {
        const int row0 = u.pm * BM + wr * 64 + fr, col0 = u.pn * HALF + wc * 32 + 8 * fq;
#pragma unroll
        for (int ai = 0; ai < 2; ++ai)
#pragma unroll
            for (int m = 0; m < 4; ++m) {
                bf16_t* rowp = nt_blk ? O + (((size_t)u.pm * nt_blk + (col0 >> 6)) * 2 + ai) * (HALF * BK) + (lds_byte(wr * 64 + fr + m * 16, col0 & 63) >> 1)
                                      : O + (size_t)(row0 + ai * HALF + m * 16) * ldc + col0;
                const float rs = (ssq ? rsqrtf(ssq[row0 + ai * HALF + m * 16] * (1.f / 2048.f) + 1e-6f) : 1.f) * oscale;
                const float nrl = -1.4426950408889634f * rs, rs2 = rs * rs;
                u32x4 w;
#pragma unroll
                for (int n = 0; n < 2; ++n)
#pragma unroll
                    for (int hh = 0; hh < 2; ++hh) {
                        const f32x2 g = {acc[ai][0][m][n][2 * hh], acc[ai][0][m][n][2 * hh + 1]}, uu = {acc[ai][1][m][n][2 * hh], acc[ai][1][m][n][2 * hh + 1]};
                        const f32x2 t = g * nrl; f32x2 ex; ex.x = __builtin_amdgcn_exp2f(t.x); ex.y = __builtin_amdgcn_exp2f(t.y);
                        const f32x2 d = ex + 1.0f; f32x2 r; r.x = __builtin_amdgcn_rcpf(d.x); r.y = __builtin_amdgcn_rcpf(d.y);
                        const f32x2 o = (g * uu) * (r * rs2);
                        w[2 * n + hh] = cvt_pk_bf16(o.x, o.y);
                    }
                __builtin_nontemporal_store(w, (u32x4*)rowp);
            }
    }
};
struct EpiResid {
    static constexpr bool PERM = false, AFTER_DRAIN = false, MIDHOOK = false;
    const float* base; float* out; float scale;
    __device__ __forceinline__ void operator()(const f32x4 (&acc)[2][2][4][2], const Unit& u, int wr, int wc, int fr, int fq) const {
        const int col0 = u.pn * BM + wc * 32 + 4 * fq;
#pragma unroll
        for (int ai = 0; ai < 2; ++ai)
#pragma unroll
            for (int m = 0; m < 4; ++m) { const size_t off = (size_t)(u.pm * BM + ai * HALF + wr * 64 + m * 16 + fr) * 2048 + col0;
#pragma unroll
                for (int bj = 0; bj < 2; ++bj)
#pragma unroll
                    for (int n = 0; n < 2; ++n) { const f32x4 bs = *(const f32x4*)(base + off + bj * HALF + n * 16); *(f32x4*)(out + off + bj * HALF + n * 16) = bs + acc[ai][bj][m][n] * scale; } }
    }
};
struct EpiQK {
    static constexpr bool PERM = true, AFTER_DRAIN = false, MIDHOOK = false;
    bf16_t* Q; bf16_t* KF; float qscale; const float* ssq;
    __device__ __forceinline__ void operator()(const f32x4 (&acc)[2][2][4][2], const Unit& u, int wr, int wc, int fr, int fq) const {
        const int row0 = u.pm * BM + wr * 64 + fr;
        if (u.pn < 8) {
            const int col0 = u.pn * BM + wc * 32 + 8 * fq;
#pragma unroll
            for (int ai = 0; ai < 2; ++ai)
#pragma unroll
                for (int m = 0; m < 4; ++m) { bf16_t* rowp = Q + (size_t)(row0 + ai * HALF + m * 16) * 2048 + col0; const float rs = qscale * rsqrtf(ssq[row0 + ai * HALF + m * 16] * (1.f / 2048.f) + 1e-6f);
#pragma unroll
                    for (int bj = 0; bj < 2; ++bj) { const f32x4 v0 = acc[ai][bj][m][0] * rs, v1 = acc[ai][bj][m][1] * rs;
                        u32x4 w; w.x = cvt_pk_bf16(v0[0], v0[1]); w.y = cvt_pk_bf16(v0[2], v0[3]); w.z = cvt_pk_bf16(v1[0], v1[1]); w.w = cvt_pk_bf16(v1[2], v1[3]);
                        *(u32x4*)(rowp + bj * HALF) = w; } }
        } else {
#pragma unroll
            for (int bj = 0; bj < 2; ++bj) {
                const int kcol = (u.pn - 8) * BM + bj * HALF + wc * 32 + 8 * fq, kh = kcol >> 6, chunk = (kcol & 63) >> 3;
#pragma unroll
                for (int ai = 0; ai < 2; ++ai)
#pragma unroll
                    for (int m = 0; m < 4; ++m) { const int r = row0 + ai * HALF + m * 16, b = r >> 11, t = r & 2047;
                        bf16_t* p = KF + (size_t)(b * 20 + kh) * 131072 + (size_t)((t >> 5) * 8 + chunk) * 256 + (t & 31) * 8;
                        const float rs = rsqrtf(ssq[r] * (1.f / 2048.f) + 1e-6f);
                        const f32x4 v0 = acc[ai][bj][m][0] * rs, v1 = acc[ai][bj][m][1] * rs;
                        u32x4 w; w.x = cvt_pk_bf16(v0[0], v0[1]); w.y = cvt_pk_bf16(v0[2], v0[3]); w.z = cvt_pk_bf16(v1[0], v1[1]); w.w = cvt_pk_bf16(v1[2], v1[3]);
                        *(u32x4*)p = w; }
            }
        }
    }
};
struct EpiVT {
    static constexpr bool PERM = true, AFTER_DRAIN = false, MIDHOOK = false;
    bf16_t* VF; const float* ssq;
    __device__ __forceinline__ void operator()(const f32x4 (&acc)[2][2][4][2], const Unit& u, int wr, int wc, int fr, int fq) const {
#pragma unroll
        for (int bj = 0; bj < 2; ++bj) {
            const int tok = u.pn * BM + bj * HALF + wc * 32 + 8 * fq, b = tok >> 11, t = tok & 2047, g = t >> 4, ih = (t & 15) >> 3;
            f32x4 rs0 = *(const f32x4*)(ssq + tok), rs1 = *(const f32x4*)(ssq + tok + 4);
#pragma unroll
            for (int e_ = 0; e_ < 4; ++e_) { rs0[e_] = rsqrtf(rs0[e_] * (1.f / 2048.f) + 1e-6f); rs1[e_] = rsqrtf(rs1[e_] * (1.f / 2048.f) + 1e-6f); }
#pragma unroll
            for (int ai = 0; ai < 2; ++ai)
#pragma unroll
                for (int m = 0; m < 4; ++m) { const int r = u.pm * BM + ai * HALF + wr * 64 + m * 16 + fr, vh = r >> 6, d = r & 63, d0 = d >> 5, dl = d & 31;
                    bf16_t* p = VF + (size_t)(b * 20 + vh) * 131072 + (size_t)((g * 2 + d0) * 2) * 256 + dl * 8 + ih * 4;
                    const f32x4 v0 = acc[ai][bj][m][0] * rs0, v1 = acc[ai][bj][m][1] * rs1;
                    u32x2 w0, w1; w0.x = cvt_pk_bf16(v0[0], v0[1]); w0.y = cvt_pk_bf16(v0[2], v0[3]); w1.x = cvt_pk_bf16(v1[0], v1[1]); w1.y = cvt_pk_bf16(v1[2], v1[3]);
                    *(u32x2*)p = w0;
                    *(u32x2*)(p + 256) = w1; }
        }
    }
};

struct InProjOrder {
    StaticOrder qk, vt; int nqk, ntot, G, c; const bf16_t* X; const bf16_t* Wqk; const bf16_t* Wv;
    __device__ void init(int M, int NQK_, int NVT_, int G_, int c_, const bf16_t* X_, const bf16_t* W_, int K) {
        qk.init(M, NQK_, G_, c_); vt.init(NVT_, M, G_, c_); nqk = qk.nwg; ntot = qk.nwg + vt.nwg; G = G_; c = c_; X = X_; Wqk = W_; Wv = W_ + (size_t)NQK_ * K; }
    __device__ bool next(int i, Unit& u) const { const long L = (long)i * G + c; if (L >= ntot) return false;
        if (L < nqk) { u.ty = 0; qk.map((int)L, u); } else { u.ty = 1; vt.map((int)L - nqk, u); } return true; }
    __device__ __forceinline__ const char* pa(const Gemm&, const Unit& u, size_t tstep) const { return (const char*)(u.ty ? Wv : X) + (size_t)u.pm * tstep; }
    __device__ __forceinline__ const char* pb(const Gemm&, const Unit& u, size_t tstep) const { return (const char*)(u.ty ? X : Wqk) + (size_t)u.pn * tstep; }
    __device__ __forceinline__ void a_ready(const Unit&) const {}
    __device__ __forceinline__ void done(const Unit&) const {}
};
struct EpiInProj {
    static constexpr bool PERM = true, AFTER_DRAIN = false, MIDHOOK = false;
    EpiQK qk; EpiVT vt;
    __device__ __forceinline__ void operator()(const f32x4 (&acc)[2][2][4][2], const Unit& u, int wr, int wc, int fr, int fq) const { if (u.ty == 0) qk(acc, u, wr, wc, fr, fq); else vt(acc, u, wr, wc, fr, fq); }
};

template <bool MID, bool BASE16, bool F32OUT, bool W16, bool W8> struct EpiResidStat {
    static constexpr bool PERM = true, AFTER_DRAIN = false, MIDHOOK = MID;
    const void* base; float* out; bf16_t* xb16; unsigned char* xb8; float* ssq; float scale; const float* ssqy;
    __device__ __forceinline__ void mid(f32x4 (&acc)[2][2][4][2], const Unit& u, int wr, int wc, int fr, int fq) const {
#pragma unroll
        for (int ai = 0; ai < 2; ++ai)
#pragma unroll
            for (int m = 0; m < 4; ++m) { const int r = u.pm * BM + ai * HALF + wr * 64 + m * 16 + fr; const f32x2 sy = *(const f32x2*)(ssqy + 2 * r);
                const float ratio = rsqrtf(sy.x * (1.f / 1024.f) + 1e-6f) * sqrtf(sy.y * (1.f / 1024.f) + 1e-6f);
#pragma unroll
                for (int bj = 0; bj < 2; ++bj)
#pragma unroll
                    for (int n = 0; n < 2; ++n) acc[ai][bj][m][n] *= ratio; }
    }
    __device__ __forceinline__ void operator()(const f32x4 (&acc)[2][2][4][2], const Unit& u, int wr, int wc, int fr, int fq) const {
        const int col0 = u.pn * BM + wc * 32 + 8 * fq;
#pragma unroll
        for (int ai = 0; ai < 2; ++ai) {
            u32x4 b16[4][2]; f32x4 b32[4][2][2]; float sy[4];
#pragma unroll
            for (int m = 0; m < 4; ++m) { const int r = u.pm * BM + ai * HALF + wr * 64 + m * 16 + fr; const size_t off = (size_t)r * 2048 + col0;
                if (MID) sy[m] = ssqy[2 * r + 1];
#pragma unroll
                for (int bj = 0; bj < 2; ++bj) { const size_t o = off + bj * HALF;
                    if constexpr (BASE16) b16[m][bj] = *(const u32x4*)((const bf16_t*)base + o);
                    else { b32[m][bj][0] = *(const f32x4*)((const float*)base + o); b32[m][bj][1] = *(const f32x4*)((const float*)base + o + 4); } } }
#pragma unroll
            for (int m = 0; m < 4; ++m) { const int r = u.pm * BM + ai * HALF + wr * 64 + m * 16 + fr; const size_t off = (size_t)r * 2048 + col0;
                float sc = scale; if (MID) sc *= rsqrtf(sy[m] * (1.f / 1024.f) + 1e-6f);
                float s = 0.f;
#pragma unroll
                for (int bj = 0; bj < 2; ++bj) { const size_t o = off + bj * HALF;
                    f32x4 bs0, bs1;
                    if constexpr (BASE16) { const u32x4 bw = b16[m][bj];
                        bs0 = (f32x4){__uint_as_float(bw.x << 16), __uint_as_float(bw.x & 0xffff0000u), __uint_as_float(bw.y << 16), __uint_as_float(bw.y & 0xffff0000u)};
                        bs1 = (f32x4){__uint_as_float(bw.z << 16), __uint_as_float(bw.z & 0xffff0000u), __uint_as_float(bw.w << 16), __uint_as_float(bw.w & 0xffff0000u)}; }
                    else { bs0 = b32[m][bj][0]; bs1 = b32[m][bj][1]; }
                    const f32x4 v0 = bs0 + acc[ai][bj][m][0] * sc, v1 = bs1 + acc[ai][bj][m][1] * sc;
                    if constexpr (F32OUT) { *(f32x4*)(out + o) = v0; *(f32x4*)(out + o + 4) = v1; }
                    s += ((v0[0] * v0[0] + v0[1] * v0[1]) + (v0[2] * v0[2] + v0[3] * v0[3])) + ((v1[0] * v1[0] + v1[1] * v1[1]) + (v1[2] * v1[2] + v1[3] * v1[3]));
                    if constexpr (W16) { u32x4 w; w.x = cvt_pk_bf16(v0[0], v0[1]); w.y = cvt_pk_bf16(v0[2], v0[3]); w.z = cvt_pk_bf16(v1[0], v1[1]); w.w = cvt_pk_bf16(v1[2], v1[3]); *(u32x4*)(xb16 + o) = w; }
                    if constexpr (W8) { u32x2 w; w.x = pk4_fp8(v0[0], v0[1], v0[2], v0[3]); w.y = pk4_fp8(v1[0], v1[1], v1[2], v1[3]); *(u32x2*)(xb8 + o) = w; } }
                s += __shfl_xor(s, 16); s += __shfl_xor(s, 32);
                if (fq == 0) __hip_atomic_fetch_add(ssq + r, s, __ATOMIC_RELAXED, __HIP_MEMORY_SCOPE_AGENT); }
            asm volatile("" ::: "memory");
        }
    }
};
template <bool F> struct Frags { bf16x8 At[4][2], B0[2][2], B1[2][2]; };
template <> struct Frags<true> { i32x8 At[4], B0[2], B1[2]; };
template <class Epi, class Sched, bool ALIGN_EPI = false, bool SP2 = false, bool FP8 = false>
__device__ __forceinline__ void gemm_phase(PG8_LAS unsigned char* lds, const Gemm g, const Sched& S, const Epi& E, const int wave_s  ) {
    const int tid_ = wave_s * 64 + lane_id();
    const int tid = tid_, wid = wave_s, lane = tid & 63, wr = wid >> 2, wc = wid & 3, fr = lane & 15, fq = lane >> 4;
    const int K = g.K, nt = K / BK, LD = g.blk ? BK : g.ld;
    unsigned voffA[2], voffB[2];
#pragma unroll
    for (int i = 0; i < 2; ++i) { int R, C; stage_rc(tid * 16 + i * 8192, R, C); const int Rb = Epi::PERM ? ((R & ~31) + perm32(R & 31)) : R;
        voffA[i] = (unsigned)(R * LD + C) * 2u; voffB[i] = (unsigned)(Rb * LD + C) * 2u;
        if (g.blk == 2) { voffA[i] = (unsigned)(tid * 16 + i * 8192); voffB[i] = voffA[i]; } }
    const size_t kstep = g.blk ? (size_t)BM * BK * 2 : (size_t)(BK * 2);
    const size_t hstep = (size_t)HALF * LD * 2;
    const size_t tstep = g.blk ? (size_t)nt * BM * BK * 2 : 2 * hstep;
    const unsigned ldsw = (unsigned)wid * 1024u;
    const int aoff = lds_byte(wr * 64 + fr, fq * 8), boff = lds_byte(wc * 32 + fr, fq * 8);
#define PG8_SA(b, h) (((b) * 2 + (h)) * HTB)
#define PG8_SB(b, h) ((4 + (b) * 2 + (h)) * HTB)
#define PG8_STAGE(bufoff, gbase, voff) do { _Pragma("unroll") for (int _i = 0; _i < 2; ++_i) \
        __builtin_amdgcn_global_load_lds((const unsigned*)((const char*)(gbase) + (voff)[_i]), (PG8_LAS unsigned*)(lds + (bufoff) + ldsw + _i * 8192), 16, 0, 0); } while (0)
#define PG8_LDA(dst, b, h) do { if constexpr (FP8) { _Pragma("unroll") for (int m = 0; m < 4; ++m) dst[m] = __builtin_shufflevector(*(const PG8_LAS i32x4*)(lds + PG8_SA(b, h) + aoff + m * 2048), *(const PG8_LAS i32x4*)(lds + PG8_SA(b, h) + aoff + m * 2048 + 1024), 0, 1, 2, 3, 4, 5, 6, 7); } \
    else { _Pragma("unroll") for (int m = 0; m < 4; ++m) _Pragma("unroll") for (int k = 0; k < 2; ++k) dst[m][k] = *(const PG8_LAS bf16x8*)(lds + PG8_SA(b, h) + aoff + m * 2048 + k * 1024); } } while (0)
#define PG8_LDB(dst, b, h) do { if constexpr (FP8) { _Pragma("unroll") for (int n = 0; n < 2; ++n) dst[n] = __builtin_shufflevector(*(const PG8_LAS i32x4*)(lds + PG8_SB(b, h) + boff + n * 2048), *(const PG8_LAS i32x4*)(lds + PG8_SB(b, h) + boff + n * 2048 + 1024), 0, 1, 2, 3, 4, 5, 6, 7); } \
    else { _Pragma("unroll") for (int n = 0; n < 2; ++n) _Pragma("unroll") for (int k = 0; k < 2; ++k) dst[n][k] = *(const PG8_LAS bf16x8*)(lds + PG8_SB(b, h) + boff + n * 2048 + k * 1024); } } while (0)
#define PG8_CAT(x) __builtin_shufflevector(__builtin_bit_cast(i32x4, (x)[0]), __builtin_bit_cast(i32x4, (x)[1]), 0, 1, 2, 3, 4, 5, 6, 7)
#define PG8_MMA(ai, bj, At, Bt) do { __builtin_amdgcn_s_setprio(1); if constexpr (FP8) { _Pragma("unroll") for (int m = 0; m < 4; ++m) _Pragma("unroll") for (int n = 0; n < 2; ++n) \
        asm volatile("v_mfma_f32_16x16x128_f8f6f4 %0, %1, %2, %0" : "+v"(acc[ai][bj][m][n]) : "v"(Bt[n]), "v"(At[m])); } else { \
        _Pragma("unroll") for (int m = 0; m < 4; ++m) _Pragma("unroll") for (int n = 0; n < 2; ++n) _Pragma("unroll") for (int k = 0; k < 2; ++k) \
        acc[ai][bj][m][n] = __builtin_amdgcn_mfma_f32_16x16x32_bf16(Bt[n][k], At[m][k], acc[ai][bj][m][n], 0, 0, 0); } __builtin_amdgcn_s_setprio(0); } while (0)
#define PG8_WAIT_V(n) asm volatile("s_waitcnt vmcnt(" #n ")" ::: "memory")
#define PG8_WAIT_L(n) asm volatile("s_waitcnt lgkmcnt(" #n ")" ::: "memory")
#define PG8_BAR __builtin_amdgcn_s_barrier()
#define PG8_SCHED __builtin_amdgcn_sched_barrier(0)
    Unit cur, nxt; int ui = 0;
    if (!S.next(0, cur)) return;
    f32x4 acc[2][2][4][2];
#pragma unroll
    for (int a = 0; a < 2; ++a)
#pragma unroll
        for (int b = 0; b < 2; ++b)
#pragma unroll
            for (int m = 0; m < 4; ++m)
#pragma unroll
                for (int n = 0; n < 2; ++n) acc[a][b][m][n] = (f32x4){0.f, 0.f, 0.f, 0.f};
    Frags<FP8> frg_; auto& At = frg_.At; auto& B0 = frg_.B0; auto& B1 = frg_.B1;
    const char* cA = S.pa(g, cur, tstep); const char* cB = S.pb(g, cur, tstep);
    S.a_ready(cur);
    if constexpr (SP2) {
        PG8_STAGE(PG8_SB(0, 0), cB, voffB); PG8_STAGE(PG8_SB(0, 1), cB + hstep, voffB); PG8_STAGE(PG8_SA(0, 0), cA, voffA); PG8_STAGE(PG8_SA(0, 1), cA + hstep, voffA);
        if (wr == 1) PG8_BAR;
        PG8_WAIT_V(2); PG8_BAR;
        PG8_STAGE(PG8_SB(1, 0), cB + kstep, voffB); PG8_STAGE(PG8_SA(1, 0), cA + kstep, voffA); PG8_STAGE(PG8_SB(1, 1), cB + hstep + kstep, voffB);
        PG8_WAIT_V(6); PG8_BAR;
    } else {
        PG8_STAGE(PG8_SB(0, 0), cB, voffB); PG8_STAGE(PG8_SA(0, 0), cA, voffA); PG8_STAGE(PG8_SB(0, 1), cB + hstep, voffB); PG8_STAGE(PG8_SA(0, 1), cA + hstep, voffA);
        if (wr == 1) PG8_BAR;
        PG8_WAIT_V(4); PG8_BAR;
        PG8_STAGE(PG8_SB(1, 0), cB + kstep, voffB); PG8_STAGE(PG8_SA(1, 0), cA + kstep, voffA); PG8_STAGE(PG8_SB(1, 1), cB + hstep + kstep, voffB);
        PG8_WAIT_V(6); PG8_BAR;
    }
    for (;;) {
        const bool has_next = S.next(ui + 1, nxt);
        const char* nA = has_next ? S.pa(g, nxt, tstep) : cA; const char* nB = has_next ? S.pb(g, nxt, tstep) : cB;
        for (int t = 0; t < nt; t += 2) {
            if constexpr (Epi::MIDHOOK) { if (t == (nt >> 1)) E.mid(acc, cur, wr, wc, fr, fq); }
            const bool last = (t == nt - 2);
            const char* a1 = cA + (size_t)(t + 1) * kstep;
            const char* a2 = last ? nA : cA + (size_t)(t + 2) * kstep; const char* b2 = last ? nB : cB + (size_t)(t + 2) * kstep;
            const char* a3 = a2 + kstep; const char* b3 = b2 + kstep;
            if (last && has_next) S.a_ready(nxt);
            if constexpr (SP2) {
            PG8_LDB(B0, 0, 0); PG8_LDB(B1, 0, 1); PG8_SCHED; PG8_LDA(At, 0, 0); PG8_STAGE(PG8_SA(1, 1), a1 + hstep, voffA);
            PG8_WAIT_V(8); PG8_WAIT_L(0); PG8_BAR; PG8_MMA(0, 0, At, B0); PG8_MMA(0, 1, At, B1); PG8_BAR; PG8_SCHED;
            PG8_LDA(At, 0, 1); PG8_STAGE(PG8_SB(0, 0), b2, voffB); PG8_STAGE(PG8_SB(0, 1), b2 + hstep, voffB); PG8_STAGE(PG8_SA(0, 0), a2, voffA);
            PG8_WAIT_V(8); PG8_WAIT_L(0); PG8_BAR; PG8_MMA(1, 0, At, B0); PG8_MMA(1, 1, At, B1); PG8_BAR; PG8_SCHED;
            PG8_LDB(B0, 1, 0); PG8_LDB(B1, 1, 1); PG8_SCHED; PG8_LDA(At, 1, 0); PG8_STAGE(PG8_SA(0, 1), a2 + hstep, voffA);
            PG8_WAIT_V(8); PG8_WAIT_L(0); PG8_BAR; PG8_MMA(0, 0, At, B0); PG8_MMA(0, 1, At, B1); PG8_BAR; PG8_SCHED;
            PG8_LDA(At, 1, 1); PG8_STAGE(PG8_SB(1, 0), b3, voffB); PG8_STAGE(PG8_SB(1, 1), b3 + hstep, voffB); PG8_STAGE(PG8_SA(1, 0), a3, voffA);
            PG8_WAIT_V(8); PG8_WAIT_L(0); PG8_BAR; PG8_MMA(1, 0, At, B0); PG8_MMA(1, 1, At, B1); PG8_BAR; PG8_SCHED;
            } else {
            PG8_LDB(B0, 0, 0); PG8_SCHED; PG8_LDA(At, 0, 0); PG8_STAGE(PG8_SA(1, 1), a1 + hstep, voffA);
            PG8_WAIT_L(8); PG8_BAR; PG8_WAIT_L(0); PG8_MMA(0, 0, At, B0); PG8_BAR; PG8_SCHED;
            PG8_LDB(B1, 0, 1); PG8_STAGE(PG8_SB(0, 0), b2, voffB);
            PG8_BAR; PG8_WAIT_L(0); PG8_MMA(0, 1, At, B1); PG8_BAR;
            PG8_LDA(At, 0, 1); PG8_STAGE(PG8_SA(0, 0), a2, voffA);
            PG8_BAR; PG8_WAIT_L(0); PG8_MMA(1, 0, At, B0); PG8_BAR; PG8_SCHED;
            PG8_STAGE(PG8_SB(0, 1), b2 + hstep, voffB);
            PG8_WAIT_V(6); PG8_BAR; PG8_MMA(1, 1, At, B1); PG8_BAR;
            PG8_LDB(B0, 1, 0); PG8_SCHED; PG8_LDA(At, 1, 0); PG8_STAGE(PG8_SA(0, 1), a2 + hstep, voffA);
            PG8_WAIT_L(8); PG8_BAR; PG8_WAIT_L(0); PG8_MMA(0, 0, At, B0); PG8_BAR; PG8_SCHED;
            PG8_LDB(B1, 1, 1); PG8_STAGE(PG8_SB(1, 0), b3, voffB);
            PG8_BAR; PG8_WAIT_L(0); PG8_MMA(0, 1, At, B1); PG8_BAR;
            PG8_LDA(At, 1, 1); PG8_STAGE(PG8_SA(1, 0), a3, voffA);
            PG8_BAR; PG8_WAIT_L(0); PG8_MMA(1, 0, At, B0); PG8_BAR; PG8_SCHED;
            PG8_STAGE(PG8_SB(1, 1), b3 + hstep, voffB);
            PG8_WAIT_V(6); PG8_BAR; PG8_MMA(1, 1, At, B1); PG8_BAR;
            }
        }
        if constexpr (FP8) { asm volatile("s_nop 15\n\ts_nop 15" ::: "memory"); }
        if constexpr (ALIGN_EPI) { if (wr == 0) PG8_BAR; }
        if constexpr (!Epi::AFTER_DRAIN) { E(acc, cur, wr, wc, fr, fq); S.done(cur); }
        if (!has_next) break;
#pragma unroll
        for (int a = 0; a < 2; ++a)
#pragma unroll
            for (int b = 0; b < 2; ++b)
#pragma unroll
                for (int m = 0; m < 4; ++m)
#pragma unroll
                    for (int n = 0; n < 2; ++n) acc[a][b][m][n] = (f32x4){0.f, 0.f, 0.f, 0.f};
        cur = nxt; cA = nA; cB = nB; ++ui;
        if constexpr (ALIGN_EPI) { if (wr == 1) PG8_BAR; }
    }
    PG8_WAIT_V(0);
    if constexpr (!ALIGN_EPI) { if (wr == 0) PG8_BAR; }
    PG8_BAR;
    if constexpr (Epi::AFTER_DRAIN) { E.fused(acc, cur, wr, wc, fr, fq, lds, wid, lane); S.done(cur); }
#undef PG8_SA
#undef PG8_SB
#undef PG8_STAGE
#undef PG8_LDA
#undef PG8_LDB
#undef PG8_MMA
#undef PG8_CAT
#undef PG8_WAIT_V
#undef PG8_WAIT_L
#undef PG8_BAR
#undef PG8_SCHED
}
}
#define LAS __attribute__((address_space(3)))
typedef unsigned short bf16_t;
typedef short bf16x8 __attribute__((ext_vector_type(8)));
typedef float f32x2 __attribute__((ext_vector_type(2)));
typedef float f32x4 __attribute__((ext_vector_type(4)));
typedef float f32x16 __attribute__((ext_vector_type(16)));
typedef unsigned u32x2 __attribute__((ext_vector_type(2)));
typedef unsigned u32x4 __attribute__((ext_vector_type(4)));
constexpr int DM = 2048, SEQ = 2048, NBATCH = 16, MTOK = NBATCH * SEQ, DFF = 5504, NKVH = 20;
constexpr int NQK = 3328;
constexpr int NVT = 1280;
constexpr int LDH = 5568;
constexpr float EPS = 1e-6f;
constexpr float LOG2E = 1.4426950408889634f;
constexpr float QSCALE = 0.125f * LOG2E;
constexpr int NWAVES = 8;
constexpr int LDS_STAGE = 131072, LDS_BYTES = LDS_STAGE + 256;
constexpr size_t MiB = 1u << 20;
constexpr size_t WS_WGU1 = 0, WS_WD1 = 43 * MiB, WS_WIN = WS_WD1 + 22 * MiB, WS_WOUT = WS_WIN + 18 * MiB, WS_WGU2 = WS_WOUT + 8 * MiB, WS_WD2 = WS_WGU2 + 43 * MiB;
constexpr size_t WS_HN = 156 * MiB;
constexpr size_t WS_H = 284 * MiB;
constexpr size_t WS_Q = WS_H, WS_KF = WS_H + 128 * MiB, WS_VF = WS_H + 208 * MiB;
constexpr size_t WS_Y = 636 * MiB;
constexpr size_t WS_SSQ = 764 * MiB;
constexpr size_t WS_CTL = 765 * MiB, CTL_BYTES = 16384;
constexpr size_t WS_X2F8 = 768 * MiB;
constexpr size_t WS_X2B = 832 * MiB;
constexpr size_t WS_END = 960 * MiB;
static_assert(WS_H + (size_t)MTOK * LDH * 2 <= WS_Y, "H fits");
static_assert(WS_WD2 + 22 * MiB <= WS_HN && (size_t)2048 * LDH * 2 <= 22 * MiB, "weights fit");

__device__ __forceinline__ unsigned pk2(float lo, float hi) { unsigned r; asm volatile("v_cvt_pk_bf16_f32 %0, %1, %2" : "=v"(r) : "v"(lo), "v"(hi)); return r; }
__device__ __forceinline__ float bf_lo(unsigned w) { return __uint_as_float(w << 16); }
__device__ __forceinline__ float bf_hi(unsigned w) { return __uint_as_float(w & 0xffff0000u); }
__device__ __forceinline__ float wave_sum(float v) {
#pragma unroll
    for (int o = 1; o < 64; o <<= 1) v += __shfl_xor(v, o);
    return v;
}

__device__ __forceinline__ int dest_row0(int type, int n0) {
    if (type == 0) return n0;
    if (type == 1) return (n0 >> 7) * 256;
    if (type == 2) return (n0 >> 7) * 256 + 128;
    if (n0 < 1024) return n0;
    if (n0 < 1280) return 2048 + (n0 - 1024);
    if (n0 < 1536) return 3328 + (n0 - 1280);
    if (n0 < 2560) return 1024 + (n0 - 1536);
    if (n0 < 3584) return 2304 + (n0 - 2560);
    return n0;
}
__device__ __forceinline__ unsigned pk4_fp8w(float a, float b, float c, float d) {
    a = fminf(fmaxf(a, -448.f), 448.f); b = fminf(fmaxf(b, -448.f), 448.f); c = fminf(fmaxf(c, -448.f), 448.f); d = fminf(fmaxf(d, -448.f), 448.f);
    unsigned w = 0; w = __builtin_amdgcn_cvt_pk_fp8_f32(a, b, w, false); w = __builtin_amdgcn_cvt_pk_fp8_f32(c, d, w, true); return w; }
constexpr float W8_SCALE = 256.f;
template <bool FP8 = false> __device__ __forceinline__ void transpose_item(const float* __restrict__ W, int K, int N, bf16_t* __restrict__ WT, int type, int item, int lane, const float* __restrict__ gk = nullptr, const float* __restrict__ gk2 = nullptr, int ldk = 0, int blk_nt = 0) {
    if (ldk == 0) ldk = K;
    const int nkc = K >> 6, nb = item / nkc, kc = item - nb * nkc, n0 = nb * 128, k0 = kc * 64;
    const int drow = dest_row0(type, n0) + 2 * lane;
    const float* src = W + (size_t)k0 * N + n0 + 2 * lane;
    bf16_t* d0 = WT + (size_t)drow * ldk + k0;
    int img_off1 = 0;
    if (blk_nt) {
        const int rl = drow & 255, pos = (rl & ~31) + pg8::invperm32(rl & 31);
        d0 = WT + (((size_t)(drow >> 8) * blk_nt + kc) * 2 + (pos >> 7)) * 8192; ldk = 0;
        img_off1 = pos & 127; }
#pragma unroll 2
    for (int kb = 0; kb < 8; ++kb) {
        f32x2 v[8];
#pragma unroll
        for (int i = 0; i < 8; ++i) v[i] = *(const f32x2*)(src + (size_t)(kb * 8 + i) * N);
        if (gk) {
            const float* gp = (gk2 && k0 >= 1024) ? gk2 + (k0 - 1024) + kb * 8 : gk + k0 + kb * 8;
#pragma unroll
            for (int i = 0; i < 8; ++i) v[i] *= gp[i];
        }
        if constexpr (FP8) {
            u32x2 a, b;
            a.x = pk4_fp8w(v[0].x * W8_SCALE, v[1].x * W8_SCALE, v[2].x * W8_SCALE, v[3].x * W8_SCALE); a.y = pk4_fp8w(v[4].x * W8_SCALE, v[5].x * W8_SCALE, v[6].x * W8_SCALE, v[7].x * W8_SCALE);
            b.x = pk4_fp8w(v[0].y * W8_SCALE, v[1].y * W8_SCALE, v[2].y * W8_SCALE, v[3].y * W8_SCALE); b.y = pk4_fp8w(v[4].y * W8_SCALE, v[5].y * W8_SCALE, v[6].y * W8_SCALE, v[7].y * W8_SCALE);
            unsigned char* d8 = (unsigned char*)WT + (size_t)drow * ldk + k0 + kb * 8;
            *(u32x2*)d8 = a; *(u32x2*)(d8 + ldk) = b;
            continue;
        }
        u32x4 a, b;
        a.x = pk2(v[0].x, v[1].x); a.y = pk2(v[2].x, v[3].x); a.z = pk2(v[4].x, v[5].x); a.w = pk2(v[6].x, v[7].x);
        b.x = pk2(v[0].y, v[1].y); b.y = pk2(v[2].y, v[3].y); b.z = pk2(v[4].y, v[5].y); b.w = pk2(v[6].y, v[7].y);
        if (blk_nt) { *(u32x4*)(d0 + (pg8::lds_byte(img_off1, kb * 8) >> 1)) = a; *(u32x4*)(d0 + (pg8::lds_byte(img_off1 + 1, kb * 8) >> 1)) = b; }
        else { *(u32x4*)(d0 + kb * 8) = a; *(u32x4*)(d0 + ldk + kb * 8) = b; }
    }
}
__device__ __forceinline__ void rms_row_bf16(const float* xrow, const float* __restrict__ g, bf16_t* orow, int lane) {
    const f32x4* xr = (const f32x4*)xrow + lane;
    f32x4 v[8]; float s = 0.f;
#pragma unroll
    for (int j = 0; j < 8; ++j) { v[j] = __builtin_nontemporal_load(xr + 64 * j); s += (v[j].x * v[j].x + v[j].y * v[j].y) + (v[j].z * v[j].z + v[j].w * v[j].w); }
    const float rstd = rsqrtf(wave_sum(s) * (1.f / DM) + EPS);
    u32x2* o8 = (u32x2*)orow + lane;
#pragma unroll
    for (int j = 0; j < 8; ++j) { const f32x4 gv = ((const f32x4*)g)[lane + 64 * j]; u32x2 w; w.x = pk2(v[j].x * rstd * gv.x, v[j].y * rstd * gv.y); w.y = pk2(v[j].z * rstd * gv.z, v[j].w * rstd * gv.w); o8[64 * j] = w; }
}
__device__ __forceinline__ void rms_row_f32(float* xrow, const float* __restrict__ g, int lane) {
    f32x4* xr = (f32x4*)xrow + lane;
    f32x4 v[8]; float s = 0.f;
#pragma unroll
    for (int j = 0; j < 8; ++j) { v[j] = xr[64 * j]; s += (v[j].x * v[j].x + v[j].y * v[j].y) + (v[j].z * v[j].z + v[j].w * v[j].w); }
    const float rstd = rsqrtf(wave_sum(s) * (1.f / DM) + EPS);
#pragma unroll
    for (int j = 0; j < 8; ++j) { const f32x4 gv = ((const f32x4*)g)[lane + 64 * j]; xr[64 * j] = v[j] * rstd * gv; }
}
__device__ __forceinline__ void final_row(const bf16_t* xrow, float ssq, const float* __restrict__ g, float* orow, int lane) {
    const float rstd = rsqrtf(ssq * (1.f / DM) + EPS);
#pragma unroll
    for (int j = 0; j < 4; ++j) { const u32x4 w = ((const u32x4*)xrow)[lane + 64 * j]; const float* gp = g + (lane + 64 * j) * 8; const f32x4 g0 = *(const f32x4*)gp, g1 = *(const f32x4*)(gp + 4);
        f32x4 o0, o1; o0.x = bf_lo(w.x) * rstd * g0.x; o0.y = bf_hi(w.x) * rstd * g0.y; o0.z = bf_lo(w.y) * rstd * g0.z; o0.w = bf_hi(w.y) * rstd * g0.w;
        o1.x = bf_lo(w.z) * rstd * g1.x; o1.y = bf_hi(w.z) * rstd * g1.y; o1.z = bf_lo(w.w) * rstd * g1.z; o1.w = bf_hi(w.w) * rstd * g1.w;
        float* op = orow + (lane + 64 * j) * 8; __builtin_nontemporal_store(o0, (f32x4*)op); __builtin_nontemporal_store(o1, (f32x4*)(op + 4)); }
}
__device__ __forceinline__ void group_norm_row(const bf16_t* yrow, const float* __restrict__ ga, const float* __restrict__ gb, bf16_t* orow, int lane) {
    u32x4 w[4]; float sa = 0.f, sb = 0.f;
#pragma unroll
    for (int j = 0; j < 4; ++j) { w[j] = ((const u32x4*)yrow)[lane + 64 * j]; float s = 0.f;
#pragma unroll
        for (int e = 0; e < 4; ++e) { const float a = bf_lo(w[j][e]), b = bf_hi(w[j][e]); s += a * a + b * b; }
        if (j < 2) sa += s; else sb += s; }
    const float ra = rsqrtf(wave_sum(sa) * (1.f / 1024.f) + EPS), rb = rsqrtf(wave_sum(sb) * (1.f / 1024.f) + EPS);
#pragma unroll
    for (int j = 0; j < 4; ++j) { const float* g = (j < 2 ? ga : gb) + (j & 1) * 512 + lane * 8; const float r = j < 2 ? ra : rb;
        const f32x4 g0 = *(const f32x4*)g, g1 = *(const f32x4*)(g + 4); u32x4 o;
        o.x = pk2(bf_lo(w[j].x) * r * g0.x, bf_hi(w[j].x) * r * g0.y); o.y = pk2(bf_lo(w[j].y) * r * g0.z, bf_hi(w[j].y) * r * g0.w);
        o.z = pk2(bf_lo(w[j].z) * r * g1.x, bf_hi(w[j].z) * r * g1.y); o.w = pk2(bf_lo(w[j].w) * r * g1.z, bf_hi(w[j].w) * r * g1.w);
        ((u32x4*)orow)[lane + 64 * j] = o; }
}

__device__ __forceinline__ int crow(int r, int hi) { return (r & 3) + 8 * (r >> 2) + 4 * hi; }
#define MFMA32(a, b, c) __builtin_amdgcn_mfma_f32_32x32x16_bf16((a), (b), (c), 0, 0, 0)
__device__ __forceinline__ void load_k(bf16x8 (&kf)[8], const bf16_t* __restrict__ Kb, int a, int lane) {
#pragma unroll
    for (int blk = 0; blk < 2; ++blk)
#pragma unroll
        for (int d0 = 0; d0 < 4; ++d0) kf[blk * 4 + d0] = *(const bf16x8*)(Kb + (size_t)(2 * a + blk) * 2048 + d0 * 512 + lane * 8);
}
__device__ __forceinline__ void load_v(bf16x8 (&vf)[8], const bf16_t* __restrict__ Vb, int a, int lane) {
#pragma unroll
    for (int g4 = 0; g4 < 4; ++g4)
#pragma unroll
        for (int d0 = 0; d0 < 2; ++d0) vf[g4 * 2 + d0] = *(const bf16x8*)(Vb + (size_t)((4 * a + g4) * 2 + d0) * 512 + lane * 8);
}
__device__ __forceinline__ bf16x8 pack8(const float (&A)[32], int base) {
    u32x4 w; w.x = pk2(A[base], A[base + 1]); w.y = pk2(A[base + 2], A[base + 3]); w.z = pk2(A[base + 4], A[base + 5]); w.w = pk2(A[base + 6], A[base + 7]);
    return __builtin_bit_cast(bf16x8, w);
}
__device__ __forceinline__ void pv_acc(f32x16 (&o)[2], const float (&A)[32], const bf16x8 (&vf)[8]) {
#pragma unroll
    for (int g4 = 0; g4 < 4; ++g4) { const bf16x8 pa = pack8(A, 8 * g4); o[0] = MFMA32(pa, vf[g4 * 2], o[0]); o[1] = MFMA32(pa, vf[g4 * 2 + 1], o[1]); }
}
__device__ __forceinline__ void qk_tile(float (&z)[32], const bf16x8 (&kf)[8], const bf16x8 (&qr)[4]) {
    f32x16 p0 = {}, p1 = {};
#pragma unroll
    for (int d0 = 0; d0 < 4; ++d0) { p0 = MFMA32(kf[d0], qr[d0], p0); p1 = MFMA32(kf[4 + d0], qr[d0], p1); }
#pragma unroll
    for (int r = 0; r < 16; ++r) { z[r] = p0[r]; z[16 + r] = p1[r]; }
}
template <int BLK> __device__ __forceinline__ void sb_block(f32x16 (&o)[2], float& carry, const f32x16& p, const bf16x8 (&vf)[8], int a, bool diag, int qpos, int hi) {
    float u[16], be[16];
#pragma unroll
    for (int i = 0; i < 16; ++i) { const float e = __builtin_amdgcn_exp2f(fminf(p[i], 126.f)); const float uu = __builtin_amdgcn_rcpf(1.0f + e); u[i] = uu; be[i] = e * uu; }
    if (diag) {
#pragma unroll
        for (int i = 0; i < 16; ++i) { const int key = 64 * a + 32 * BLK + crow(i, hi); if (key >= qpos) { u[i] = 1.f; be[i] = 0.f; } }
    }
    float X[16], T[4], oth[4], PS[4], SS[4];
#pragma unroll
    for (int k = 0; k < 4; ++k) { const float x2 = u[4 * k + 3], x1 = x2 * u[4 * k + 2], x0 = x1 * u[4 * k + 1]; X[4 * k + 3] = 1.f; X[4 * k + 2] = x2; X[4 * k + 1] = x1; X[4 * k] = x0; T[k] = x0 * u[4 * k]; }
#pragma unroll
    for (int k = 0; k < 4; ++k) { oth[k] = __shfl_xor(T[k], 32); PS[k] = T[k] * oth[k]; }
    SS[3] = carry;
#pragma unroll
    for (int k = 2; k >= 0; --k) SS[k] = SS[k + 1] * PS[k + 1];
    carry = SS[0] * PS[0];
    float A[16];
#pragma unroll
    for (int k = 0; k < 4; ++k) { const float R = hi ? SS[k] : SS[k] * oth[k];
        A[4 * k + 3] = be[4 * k + 3] * R; A[4 * k + 2] = be[4 * k + 2] * (X[4 * k + 2] * R); A[4 * k + 1] = be[4 * k + 1] * (X[4 * k + 1] * R); A[4 * k] = be[4 * k] * (X[4 * k] * R); }
#pragma unroll
    for (int j = 0; j < 2; ++j) { u32x4 w; w.x = pk2(A[8 * j], A[8 * j + 1]); w.y = pk2(A[8 * j + 2], A[8 * j + 3]); w.z = pk2(A[8 * j + 4], A[8 * j + 5]); w.w = pk2(A[8 * j + 6], A[8 * j + 7]);
        const bf16x8 pa = __builtin_bit_cast(bf16x8, w); o[0] = MFMA32(pa, vf[(2 * BLK + j) * 2], o[0]); o[1] = MFMA32(pa, vf[(2 * BLK + j) * 2 + 1], o[1]); }
}
__device__ __forceinline__ void sb_tile(f32x16 (&o)[2], float& carry, const bf16x8 (&kf)[8], const bf16x8 (&vf)[8], const bf16x8 (&qr)[4], int a, bool diag, int qpos, int hi) {
    f32x16 p0 = {}, p1 = {};
#pragma unroll
    for (int d0 = 0; d0 < 4; ++d0) { p1 = MFMA32(kf[4 + d0], qr[d0], p1); p0 = MFMA32(kf[d0], qr[d0], p0); }
    sb_block<1>(o, carry, p1, vf, a, diag, qpos, hi);
    sb_block<0>(o, carry, p0, vf, a, diag, qpos, hi);
}
__device__ __forceinline__ void store_o(const f32x16 (&o)[2], bf16_t* Yp  , float* ssqp  , LAS unsigned char* stg, int lane) {
    const int dl = lane & 31, hi = lane >> 5;
    LAS bf16_t* st = (LAS bf16_t*)stg;
#pragma unroll
    for (int d0 = 0; d0 < 2; ++d0)
#pragma unroll
        for (int r = 0; r < 16; ++r) { const unsigned w = pk2(o[d0][r], 0.f); st[crow(r, hi) * 64 + d0 * 32 + dl] = (bf16_t)(w & 0xffffu); }
    asm volatile("s_waitcnt lgkmcnt(0)" ::: "memory");
#pragma unroll
    for (int i = 0; i < 4; ++i) { const int row = i * 8 + (lane >> 3), ch = lane & 7; const u32x4 v = *(const LAS u32x4*)(st + row * 64 + ch * 8); *(u32x4*)(Yp + (size_t)row * 2048 + ch * 8) = v;
        float s = 0.f;
#pragma unroll
        for (int e = 0; e < 4; ++e) { const float a = bf_lo(v[e]), b = bf_hi(v[e]); s += a * a + b * b; }
        s += __shfl_xor(s, 1); s += __shfl_xor(s, 2); s += __shfl_xor(s, 4);
        if (ch == 0) __hip_atomic_fetch_add(ssqp + 2 * row, s, __ATOMIC_RELAXED, __HIP_MEMORY_SCOPE_AGENT); }
    asm volatile("s_waitcnt lgkmcnt(0)" ::: "memory");
}
__device__ __forceinline__ void load_kb(bf16x8 (&kf)[4], const bf16_t* __restrict__ Kb, int kb, int lane) {
#pragma unroll
    for (int d0 = 0; d0 < 4; ++d0) kf[d0] = *(const bf16x8*)(Kb + (size_t)kb * 2048 + d0 * 512 + lane * 8);
}
__device__ __forceinline__ void load_vb(bf16x8 (&vf)[4], const bf16_t* __restrict__ Vb, int kb, int lane) {
#pragma unroll
    for (int j = 0; j < 2; ++j)
#pragma unroll
        for (int d0 = 0; d0 < 2; ++d0) vf[j * 2 + d0] = *(const bf16x8*)(Vb + (size_t)((2 * kb + j) * 2 + d0) * 512 + lane * 8);
}
__device__ __forceinline__ void pv_block(f32x16 (&o)[2], const f32x16& p, const bf16x8 (&vf)[4]) {
#pragma unroll
    for (int j = 0; j < 2; ++j) { u32x4 w; w.x = pk2(p[8 * j], p[8 * j + 1]); w.y = pk2(p[8 * j + 2], p[8 * j + 3]); w.z = pk2(p[8 * j + 4], p[8 * j + 5]); w.w = pk2(p[8 * j + 6], p[8 * j + 7]);
        const bf16x8 pa = __builtin_bit_cast(bf16x8, w); o[0] = MFMA32(pa, vf[j * 2], o[0]); o[1] = MFMA32(pa, vf[j * 2 + 1], o[1]); }
}
__device__ __forceinline__ void sb_item(int b, int h, int c, const bf16_t* __restrict__ Q, const bf16_t* __restrict__ KF, const bf16_t* __restrict__ VF, bf16_t* Y, float* ssqy, LAS unsigned char* stg, int lane) {
    const int r32 = lane & 31, hi = lane >> 5, q0 = 32 * c, qpos = q0 + r32;
    const bf16_t* Qrow = Q + (size_t)(b * SEQ + qpos) * 2048 + 1024 + h * 64;
    bf16x8 qr[4];
#pragma unroll
    for (int d0 = 0; d0 < 4; ++d0) qr[d0] = *(const bf16x8*)(Qrow + d0 * 16 + hi * 8);
    const bf16_t* Kb = KF + (size_t)(b * NKVH + 4 + h) * 131072; const bf16_t* Vb = VF + (size_t)(b * NKVH + 4 + h) * 131072;
    f32x16 o[2]; o[0] = f32x16{}; o[1] = f32x16{};
    float carry = 1.f;
    bf16x8 kc[4], kn[4], vc[4], vn[4];
    int kb = c;
    load_kb(kc, Kb, kb, lane); load_vb(vc, Vb, kb, lane);
#pragma unroll 1
    for (;;) {
        const int kp = kb > 0 ? kb - 1 : 0;
        load_kb(kn, Kb, kp, lane); load_vb(vn, Vb, kp, lane);
        f32x16 p = {};
#pragma unroll
        for (int d0 = 0; d0 < 4; ++d0) p = MFMA32(kc[d0], qr[d0], p);
        float u[16], be[16];
#pragma unroll
        for (int i = 0; i < 16; ++i) { const float e = __builtin_amdgcn_exp2f(fminf(p[i], 126.f)); const float uu = __builtin_amdgcn_rcpf(1.0f + e); u[i] = uu; be[i] = e * uu; }
        if (kb == c) {
#pragma unroll
            for (int i = 0; i < 16; ++i) { if (crow(i, hi) >= r32) { u[i] = 1.f; be[i] = 0.f; } }
        }
        float X[16], T[4], oth[4], PS[4], SS[4];
#pragma unroll
        for (int k = 0; k < 4; ++k) { const float x2 = u[4 * k + 3], x1 = x2 * u[4 * k + 2], x0 = x1 * u[4 * k + 1]; X[4 * k + 3] = 1.f; X[4 * k + 2] = x2; X[4 * k + 1] = x1; X[4 * k] = x0; T[k] = x0 * u[4 * k]; }
#pragma unroll
        for (int k = 0; k < 4; ++k) { oth[k] = __shfl_xor(T[k], 32); PS[k] = T[k] * oth[k]; }
        SS[3] = carry;
#pragma unroll
        for (int k = 2; k >= 0; --k) SS[k] = SS[k + 1] * PS[k + 1];
        carry = SS[0] * PS[0];
#pragma unroll
        for (int k = 0; k < 4; ++k) { const float R = hi ? SS[k] : SS[k] * oth[k];
            p[4 * k + 3] = be[4 * k + 3] * R; p[4 * k + 2] = be[4 * k + 2] * (X[4 * k + 2] * R); p[4 * k + 1] = be[4 * k + 1] * (X[4 * k + 1] * R); p[4 * k] = be[4 * k] * (X[4 * k] * R); }
        pv_block(o, p, vc);
        if (kb == 0) break;
        if (__all(carry < 1.17549435e-38f)) break;
        --kb;
#pragma unroll
        for (int i = 0; i < 4; ++i) { kc[i] = kn[i]; vc[i] = vn[i]; }
    }
    store_o(o, Y + (size_t)(b * SEQ + q0) * 2048 + 1024 + h * 64, ssqy + (size_t)(b * SEQ + q0) * 2 + 1, stg, lane);
}
__device__ __forceinline__ void swa_item(int b, int h, int c, const bf16_t* __restrict__ Q, const bf16_t* __restrict__ KF, const bf16_t* __restrict__ VF, bf16_t* Y, float* ssqy, float sink2, float slope2, LAS unsigned char* stg, int lane) {
    const int r32 = lane & 31, hi = lane >> 5, q0 = 32 * c, qpos = q0 + r32, kv = h >> 2;
    const bf16_t* Qrow = Q + (size_t)(b * SEQ + qpos) * 2048 + h * 64;
    bf16x8 qr[4];
#pragma unroll
    for (int d0 = 0; d0 < 4; ++d0) qr[d0] = *(const bf16x8*)(Qrow + d0 * 16 + hi * 8);
    const bf16_t* Kb = KF + (size_t)(b * NKVH + kv) * 131072; const bf16_t* Vb = VF + (size_t)(b * NKVH + kv) * 131072;
    f32x16 o[2]; o[0] = f32x16{}; o[1] = f32x16{};
    float m = sink2, l = hi ? 0.f : 1.f;
    const int klo = c >= 4 ? c - 4 : 0;
    bf16x8 kc[4], kn[4], vc[4], vn[4];
    int kb = c;
    load_kb(kc, Kb, kb, lane); load_vb(vc, Vb, kb, lane);
#pragma unroll 1
    for (;;) {
        const int kp = kb > klo ? kb - 1 : klo;
        load_kb(kn, Kb, kp, lane); load_vb(vn, Vb, kp, lane);
        f32x16 p = {};
#pragma unroll
        for (int d0 = 0; d0 < 4; ++d0) p = MFMA32(kc[d0], qr[d0], p);
        const float dbase = (float)(qpos - 32 * kb - 4 * hi), sbase = slope2 * dbase;
#pragma unroll
        for (int r = 0; r < 16; ++r) p[r] = __builtin_fmaf(slope2, (float)((r & 3) + 8 * (r >> 2)), p[r]) - sbase;
        if (kb == c) {
#pragma unroll
            for (int r = 0; r < 16; ++r) p[r] = ((float)((r & 3) + 8 * (r >> 2)) <= dbase) ? p[r] : -INFINITY;
        } else if (kb + 4 == c) {
            const float dlim = dbase - 128.f;
#pragma unroll
            for (int r = 0; r < 16; ++r) p[r] = ((float)((r & 3) + 8 * (r >> 2)) > dlim) ? p[r] : -INFINITY;
        }
        float r0 = fmaxf(p[0], p[1]), r1 = fmaxf(p[2], p[3]);
#pragma unroll
        for (int r = 4; r < 16; r += 4) { r0 = fmaxf(r0, fmaxf(p[r], p[r + 1])); r1 = fmaxf(r1, fmaxf(p[r + 2], p[r + 3])); }
        float rm = fmaxf(r0, r1);
        rm = fmaxf(rm, __shfl_xor(rm, 32));
        if (__any(rm > m)) {
            const float mn = fmaxf(m, rm), f = __builtin_amdgcn_exp2f(m - mn); m = mn; l *= f;
#pragma unroll
            for (int r = 0; r < 16; ++r) { const float fr_ = __shfl(f, crow(r, hi)); o[0][r] *= fr_; o[1][r] *= fr_; }
        }
        float l0 = 0.f, l1 = 0.f;
#pragma unroll
        for (int r = 0; r < 16; r += 2) { p[r] = __builtin_amdgcn_exp2f(p[r] - m); p[r + 1] = __builtin_amdgcn_exp2f(p[r + 1] - m); l0 += p[r]; l1 += p[r + 1]; }
        l += l0 + l1;
        pv_block(o, p, vc);
        if (kb == klo) break;
        --kb;
#pragma unroll
        for (int i = 0; i < 4; ++i) { kc[i] = kn[i]; vc[i] = vn[i]; }
    }
    l += __shfl_xor(l, 32);
    const float inv = 1.0f / l;
#pragma unroll
    for (int r = 0; r < 16; ++r) { const float ir = __shfl(inv, crow(r, hi)); o[0][r] *= ir; o[1][r] *= ir; }
    store_o(o, Y + (size_t)(b * SEQ + q0) * 2048 + h * 64, ssqy + (size_t)(b * SEQ + q0) * 2, stg, lane);
}

#define XB_TMO      128
#define XB_XCNT(j)  (256  + 64 * (j))
#define XB_XSUB(j)  (1280 + 64 * (j))
#define XB_XGEN(j)  (2304 + 64 * (j))
#define XB_TOP      3328
#define XB_TOPGEN   3392
#define XCD_BAR_WORDS 3456
#define XB_SPIN_CAP (1u << 18)

__device__ __forceinline__ unsigned xb_ld(unsigned* p)              { return __hip_atomic_load(p, __ATOMIC_RELAXED, __HIP_MEMORY_SCOPE_AGENT); }
__device__ __forceinline__ unsigned xb_add(unsigned* p, unsigned v) { return __hip_atomic_fetch_add(p, v, __ATOMIC_RELAXED, __HIP_MEMORY_SCOPE_AGENT); }
__device__ __forceinline__ unsigned xb_xcc_id() { return (unsigned)__builtin_amdgcn_s_getreg((3 << 11) | 20) & 0xFu; }
#define XB_SPIN(cond, bar) do { unsigned _sp = 0; while (cond) { __builtin_amdgcn_s_sleep(1); \
    if ((++_sp & 255u) == 0u) { if (xb_ld(&(bar)[XB_TMO])) break; if (_sp > XB_SPIN_CAP) { atomicAdd(&(bar)[XB_TMO], 1u); break; } } } } while (0)

struct XcdBarrier {
    unsigned* bar; unsigned x;
    volatile LAS unsigned* st;
};

__device__ __forceinline__ XcdBarrier xcd_barrier_post(unsigned* bar, volatile LAS unsigned* st, const bool t0  ) {
    XcdBarrier b; b.bar = bar; b.x = xb_xcc_id(); b.st = st;
    if (t0) (void)xb_add(&bar[XB_XCNT(b.x)], 1u);
    return b;
}
__device__ __forceinline__ void xcd_barrier_complete(unsigned* bar, unsigned x, unsigned& nloc, unsigned& nx) {
    const unsigned G = gridDim.x * gridDim.y * gridDim.z;
    unsigned sum, cnt, mine, sp = 0u;
    for (;;) {
        sum = 0u; cnt = 0u; mine = 0u;
#pragma unroll
        for (unsigned j = 0; j < 16; ++j) { const unsigned c = xb_ld(&bar[XB_XCNT(j)]); sum += c; cnt += (c > 0u) ? 1u : 0u; mine = (j == x) ? c : mine; }
        if (sum == G) break;
        __builtin_amdgcn_s_sleep(1);
        if ((++sp & 255u) == 0u) { if (xb_ld(&bar[XB_TMO])) break; if (sp > XB_SPIN_CAP) { atomicAdd(&bar[XB_TMO], 1u); break; } }
    }
    nloc = mine > 0u ? mine : 1u; nx = cnt > 0u ? cnt : 1u;
}

__device__ __forceinline__ void xcd_barrier(const XcdBarrier& b, const bool t0  ) {
    asm volatile("s_waitcnt vmcnt(0)" ::: "memory");
    __syncthreads();
    if (t0) {
        unsigned* bar = b.bar;
        __builtin_amdgcn_s_waitcnt(0);
        unsigned nloc = b.st[0], nx = b.st[1];
        if (nloc == 0u) { xcd_barrier_complete(bar, b.x, nloc, nx); b.st[0] = nloc; b.st[1] = nx; }
        const unsigned old = xb_add(&bar[XB_XSUB(b.x)], 1u);
        const unsigned gen = old / nloc;
        if (old + 1u == (gen + 1u) * nloc) {
            __builtin_amdgcn_fence(__ATOMIC_RELEASE, "agent");
            asm volatile("s_waitcnt vmcnt(0)" ::: "memory");
            const unsigned og = xb_add(&bar[XB_TOP], 1u);
            const unsigned tg = og / nx;
            if (og + 1u == (tg + 1u) * nx) xb_add(&bar[XB_TOPGEN], 1u);
            else XB_SPIN(xb_ld(&bar[XB_TOPGEN]) == tg, bar);
            __builtin_amdgcn_fence(__ATOMIC_ACQUIRE, "agent");
            xb_add(&bar[XB_XGEN(b.x)], 1u);
            asm volatile("s_waitcnt vmcnt(0)" ::: "memory");
        } else {
            XB_SPIN(xb_ld(&bar[XB_XGEN(b.x)]) == gen, bar);
            __builtin_amdgcn_fence(__ATOMIC_ACQUIRE, "agent");
            asm volatile("s_waitcnt vmcnt(0)" ::: "memory");
        }
    }
    __syncthreads();
}

__device__ __forceinline__ int fresh_lane() { return pg8::lane_id(); }
struct Args { const float* in[16]; float* out; unsigned char* ws; };
__global__ void __launch_bounds__(NWAVES * 64, 2) hybrid_fwd(Args args) {
    extern __shared__ __attribute__((aligned(16))) unsigned char lds_raw[];
    LAS unsigned char* lds = (LAS unsigned char*)lds_raw;
    cg::grid_group grid = cg::this_grid();
    const int wave = __builtin_amdgcn_readfirstlane((int)threadIdx.x >> 6);
#define T0() (wave == 0 && pg8::lane_id() == 0)
    volatile LAS unsigned* bst = (volatile LAS unsigned*)(lds + LDS_STAGE);
    if (wave == 0) { const int l_ = pg8::lane_id(); if (l_ < 2) bst[l_] = 0u; }
    __syncthreads();
    const XcdBarrier xbar = xcd_barrier_post((unsigned*)(args.ws + WS_CTL), bst, T0());
    const int G = gridDim.x, gw = blockIdx.x * NWAVES + wave, NGW = G * NWAVES;
    unsigned char* ws = args.ws;
    const float* x = args.in[0];
    float* out = args.out;
    bf16_t* WGU1 = (bf16_t*)(ws + WS_WGU1); bf16_t* WD1 = (bf16_t*)(ws + WS_WD1); bf16_t* WIN = (bf16_t*)(ws + WS_WIN); bf16_t* WOUT = (bf16_t*)(ws + WS_WOUT);
    bf16_t* WGU2 = (bf16_t*)(ws + WS_WGU2); bf16_t* WD2 = (bf16_t*)(ws + WS_WD2);
    bf16_t* HN = (bf16_t*)(ws + WS_HN); bf16_t* HB = (bf16_t*)(ws + WS_H); bf16_t* QB = (bf16_t*)(ws + WS_Q); bf16_t* KF = (bf16_t*)(ws + WS_KF); bf16_t* VF = (bf16_t*)(ws + WS_VF);
    bf16_t* YB = (bf16_t*)(ws + WS_Y);
    float* ssq1 = (float*)(ws + WS_SSQ); float* ssq2 = ssq1 + MTOK; float* ssqy = ssq2 + MTOK; float* ssq3 = ssqy + 2 * MTOK;
    unsigned char* X2F8 = ws + WS_X2F8; bf16_t* X2B = (bf16_t*)(ws + WS_X2B);

    {
        const int lane = pg8::lane_id(), tid = wave * 64 + lane;
        constexpr int I_GU = 43 * 32, I_DN = 16 * 86, I_IN = 36 * 32, I_OUT = 16 * 32;
        constexpr int NITEMS = 4 * I_GU + 2 * I_DN + I_IN + I_OUT;
        for (int it = gw; it < NITEMS; it += NGW) {
            int r = it;
            if (r < I_GU) { transpose_item(args.in[2], DM, DFF, WGU1, 1, r, lane); continue; } r -= I_GU;
            if (r < I_GU) { transpose_item(args.in[3], DM, DFF, WGU1, 2, r, lane); continue; } r -= I_GU;
            if (r < I_DN) { transpose_item(args.in[4], DFF, DM, WD1, 0, r, lane, nullptr, nullptr, 0, DFF / 64); continue; } r -= I_DN;
            if (r < I_IN) { transpose_item(args.in[6], DM, 4608, WIN, 3, r, lane, args.in[5]); continue; } r -= I_IN;
            if (r < I_OUT) { transpose_item(args.in[10], DM, DM, WOUT, 0, r, lane, args.in[8], args.in[9]); continue; } r -= I_OUT;
            if (r < I_GU) { transpose_item<true>(args.in[12], DM, DFF, WGU2, 1, r, lane, args.in[11]); continue; } r -= I_GU;
            if (r < I_GU) { transpose_item<true>(args.in[13], DM, DFF, WGU2, 2, r, lane, args.in[11]); continue; } r -= I_GU;
            transpose_item(args.in[14], DFF, DM, WD2, 0, r, lane, nullptr, nullptr, 0, DFF / 64);
        }
        for (int m = gw; m < MTOK; m += NGW) rms_row_bf16(x + (size_t)m * DM, args.in[1], HN + (size_t)m * DM, lane);
        for (int i = blockIdx.x * (NWAVES * 64) + tid; i < 5 * MTOK; i += G * NWAVES * 64) ssq1[i] = 0.f;
    }
    if (args.ws == nullptr) grid.sync();
    xcd_barrier(xbar, T0());
    {
        pg8::Gemm g{HN, WGU1, MTOK, 2 * DFF, DM, DM, 0}; pg8::StaticOrder S; S.init(MTOK, 2 * DFF, G, (int)blockIdx.x);
        pg8::EpiSwiglu E{HB, LDH, nullptr, 1.0f, DFF / 64};
        pg8::gemm_phase<pg8::EpiSwiglu, pg8::StaticOrder, true, true>(lds, g, S, E, wave);
    }
    xcd_barrier(xbar, T0());
    {
        pg8::Gemm g{HB, WD1, MTOK, DM, DFF, LDH, 2}; pg8::StaticOrder S; S.init(MTOK, DM, G, (int)blockIdx.x, 1);
        pg8::EpiResidStat<false, false, false, true, false> E{x, nullptr, HN, nullptr, ssq1, 0.5f, nullptr};
        pg8::gemm_phase<pg8::EpiResidStat<false, false, false, true, false>, pg8::StaticOrder, true, true>(lds, g, S, E, wave);
    }
    xcd_barrier(xbar, T0());
    {
        pg8::Gemm g{HN, WIN, MTOK, NQK, DM, DM, 0}; pg8::InProjOrder S; S.init(MTOK, NQK, NVT, G, (int)blockIdx.x, HN, WIN, DM);
        pg8::EpiInProj E{pg8::EpiQK{QB, KF, QSCALE, ssq1}, pg8::EpiVT{VF, ssq1}};
        pg8::gemm_phase<pg8::EpiInProj, pg8::InProjOrder, true, true>(lds, g, S, E, wave);
    }
    xcd_barrier(xbar, T0());
    { const int lane5 = fresh_lane();
    for (int pi = gw; pi < NBATCH * 16 * 8; pi += NGW) {
        const int bh = pi >> 3, s = pi & 7, b = bh >> 4, h = bh & 15;
#pragma unroll 1
        for (int i = 0; i < 8; ++i) { const int c = 16 * (i >> 1) + ((i & 1) ? 15 - s : s); sb_item(b, h, c, QB, KF, VF, YB, ssqy, lds + wave * 4096, lane5); }
        const float sink2 = args.in[7][h] * LOG2E, slope2 = __builtin_amdgcn_exp2f(-0.5f * (float)(h + 1)) * LOG2E;
#pragma unroll 1
        for (int i = 0; i < 8; ++i) { const int c = 16 * (i >> 1) + ((i & 1) ? 15 - s : s); swa_item(b, h, c, QB, KF, VF, YB, ssqy, sink2, slope2, lds + wave * 4096, lane5); }
    }
    }
    xcd_barrier(xbar, T0());
    {
        pg8::Gemm g{YB, WOUT, MTOK, DM, DM, DM, 0}; pg8::StaticOrder S; S.init(MTOK, DM, G, (int)blockIdx.x);
        pg8::EpiResidStat<true, true, false, true, true> E{HN, nullptr, X2B, X2F8, ssq2, 1.0f, ssqy};
        pg8::gemm_phase<pg8::EpiResidStat<true, true, false, true, true>, pg8::StaticOrder, true, true>(lds, g, S, E, wave);
    }
    xcd_barrier(xbar, T0());
    {
        pg8::Gemm g{(const bf16_t*)X2F8, WGU2, MTOK, 2 * DFF, DM / 2, DM / 2, 0}; pg8::StaticOrder S; S.init(MTOK, 2 * DFF, G, (int)blockIdx.x);
        pg8::EpiSwiglu E{HB, LDH, ssq2, 1.0f / W8_SCALE, DFF / 64};
        pg8::gemm_phase<pg8::EpiSwiglu, pg8::StaticOrder, true, true, true>(lds, g, S, E, wave);
    }
    xcd_barrier(xbar, T0());
    {
        pg8::Gemm g{HB, WD2, MTOK, DM, DFF, LDH, 2}; pg8::StaticOrder S; S.init(MTOK, DM, G, (int)blockIdx.x, 1);
        pg8::EpiResidStat<false, true, false, true, false> E{X2B, nullptr, HN, nullptr, ssq3, 0.5f, nullptr};
        pg8::gemm_phase<pg8::EpiResidStat<false, true, false, true, false>, pg8::StaticOrder, true, true>(lds, g, S, E, wave);
    }
    xcd_barrier(xbar, T0());
    { const int lane11 = fresh_lane();
    for (int m = gw; m < MTOK; m += NGW) final_row(HN + (size_t)m * DM, ssq3[m], args.in[15], out + (size_t)m * DM, lane11); }
}

extern "C" void kernel_launch(void* const* d_in, const int* in_sizes, int n_in, void* d_out, int out_size, void* d_ws, size_t ws_size, hipStream_t stream) {
    static int grid_blocks = 0;
    if (grid_blocks == 0) {
        if (n_in != 16 || in_sizes[0] != MTOK * DM || out_size != MTOK * DM || ws_size < WS_END) {
            fprintf(stderr, "kernel_launch: unexpected shapes (n_in %d in0 %d out %d ws %zu)\n", n_in, n_in > 0 ? in_sizes[0] : -1, out_size, ws_size); grid_blocks = -1; return; }
        int dev = 0, cus = 0, per_cu = 0;
        hipGetDevice(&dev);
        hipDeviceGetAttribute(&cus, hipDeviceAttributeMultiprocessorCount, dev);
        hipFuncSetAttribute((const void*)hybrid_fwd, hipFuncAttributeMaxDynamicSharedMemorySize, LDS_BYTES);
        hipOccupancyMaxActiveBlocksPerMultiprocessor(&per_cu, (const void*)hybrid_fwd, NWAVES * 64, LDS_BYTES);
        if (per_cu < 1) { fprintf(stderr, "kernel_launch: occupancy query says %d blocks/CU\n", per_cu); per_cu = 1; }
        grid_blocks = cus * per_cu;
    }
    if (grid_blocks < 0) return;
    if (hipMemsetAsync((char*)d_ws + WS_CTL, 0, CTL_BYTES, stream) != hipSuccess) { fprintf(stderr, "kernel_launch: hipMemsetAsync failed\n"); return; }
    Args a{};
    for (int i = 0; i < 16; ++i) a.in[i] = (const float*)d_in[i];
    a.out = (float*)d_out; a.ws = (unsigned char*)d_ws;
    void* kargs[] = {&a};
    hipError_t e = hipLaunchCooperativeKernel((const void*)hybrid_fwd, dim3(grid_blocks), dim3(NWAVES * 64), kargs, LDS_BYTES, stream);
    if (e != hipSuccess) fprintf(stderr, "cooperative launch failed: %s (grid %d)\n", hipGetErrorString(e), grid_blocks);
}
```

```cpp
#include <hip/hip_runtime.h>
#include <hip/hip_cooperative_groups.h>
#include <cstdio>
#include <cstdint>
#include <type_traits>
namespace cg = cooperative_groups;
namespace pg8 {
#define PG8_LAS __attribute__((address_space(3)))
typedef unsigned short bf16_t;
typedef short bf16x8 __attribute__((ext_vector_type(8)));
typedef float f32x4 __attribute__((ext_vector_type(4)));
typedef unsigned u32x4 __attribute__((ext_vector_type(4)));
typedef int i32x4 __attribute__((ext_vector_type(4)));
typedef int i32x8 __attribute__((ext_vector_type(8)));
__device__ __forceinline__ int lane_id() { int l; asm volatile("v_mbcnt_lo_u32_b32 %0, -1, 0\n\tv_mbcnt_hi_u32_b32 %0, -1, %0" : "=v"(l)); return l; }
constexpr int BM = 256, BK = 64, HALF = 128, HTB = HALF * BK * 2  , STAGE_BYTES = 8 * HTB, NXCD = 8, WGM = 8;

__host__ __device__ __forceinline__ int lds_byte(int r, int c) { const int st = (r >> 4) * 2 + (c >> 5), rr = r & 15, cc = c & 31, ob = rr * 64 + cc * 2; return st * 1024 + (ob ^ (((ob >> 9) & 1) << 5)); }
__host__ __device__ __forceinline__ void stage_rc(int b, int& R, int& C) { const int st = b / 1024, sb = b % 1024, swz = sb ^ (((sb >> 9) & 1) << 5); R = (st >> 1) * 16 + swz / 64; C = (st & 1) * 32 + (swz % 64) / 2; }
__host__ __device__ __forceinline__ int perm32(int rho) { const int n = rho >> 4, i = rho & 15; return 8 * (i >> 2) + 4 * n + (i & 3); }

struct Unit { int pm, pn, ty; };
__host__ __device__ __forceinline__ int invperm32(int s) { return 16 * ((s >> 2) & 1) + 4 * (s >> 3) + (s & 3); }
struct Gemm { const bf16_t* A; const bf16_t* Bt; int M, N, K, ld, blk; };

struct StaticOrder {
    int nM, nN, nwg, G, c, rev;
    __host__ __device__ void init(int M, int N, int G_, int c_, int rev_ = 0) { nM = M / BM; nN = N / BM; nwg = nM * nN; G = G_; c = c_; rev = rev_; }
    __host__ __device__ bool next(int i, Unit& u) const {
        const long L = (long)i * G + c; if (L >= nwg) return false;
        u.ty = 0; map((int)L, u); return true;
    }
    __host__ __device__ void map(int L, Unit& u) const {
        int wgid = L; { const int q = nwg / NXCD, r = nwg % NXCD, xcd = wgid % NXCD, off = wgid / NXCD; wgid = (xcd < r ? xcd * (q + 1) : r * (q + 1) + (xcd - r) * q) + off; }
        const int nig = WGM * nN, gid = wgid / nig, fm = gid * WGM, gsz = (nM - fm) < WGM ? (nM - fm) : WGM;
        u.pm = fm + ((wgid % nig) % gsz); u.pn = (wgid % nig) / gsz; if (rev) u.pm = nM - 1 - u.pm;
    }
    __device__ __forceinline__ const char* pa(const Gemm& g, const Unit& u, size_t tstep) const { return (const char*)g.A + (size_t)u.pm * tstep; }
    __device__ __forceinline__ const char* pb(const Gemm& g, const Unit& u, size_t tstep) const { return (const char*)g.Bt + (size_t)u.pn * tstep; }
    __device__ __forceinline__ void a_ready(const Unit&) const {}
    __device__ __forceinline__ void done(const Unit&) const {}
};

__device__ __forceinline__ unsigned cvt_pk_bf16(float lo, float hi) { unsigned r; asm volatile("v_cvt_pk_bf16_f32 %0, %1, %2" : "=v"(r) : "v"(lo), "v"(hi)); return r; }
typedef float f32x2 __attribute__((ext_vector_type(2)));
typedef unsigned u32x2 __attribute__((ext_vector_type(2)));
typedef float f32x2 __attribute__((ext_vector_type(2)));
__device__ __forceinline__ unsigned pk4_fp8(float a, float b, float c, float d) {
    a = fminf(fmaxf(a, -448.f), 448.f); b = fminf(fmaxf(b, -448.f), 448.f); c = fminf(fmaxf(c, -448.f), 448.f); d = fminf(fmaxf(d, -448.f), 448.f);
    unsigned w = 0; w = __builtin_amdgcn_cvt_pk_fp8_f32(a, b, w, false); w = __builtin_amdgcn_cvt_pk_fp8_f32(c, d, w, true); return w; }
__device__ __forceinline__ float silu_mul(float g, float u) { return g * __builtin_amdgcn_rcpf(1.0f + __builtin_amdgcn_exp2f(-1.4426950408889634f * g)) * u; }

struct EpiSwiglu {
    static constexpr bool PERM = true, AFTER_DRAIN = false, MIDHOOK = false;
    bf16_t* O; int ldc; const float* ssq; float oscale; int nt_blk;
    __device__ __forceinline__ void operator()(const f32x4 (&acc)[2][2][4][2], const Unit& u, int wr, int wc, int fr, int fq) const {
        const int row0 = u.pm * BM + wr * 64 + fr, col0 = u.pn * HALF + wc * 32 + 8 * fq;
#pragma unroll
        for (int ai = 0; ai < 2; ++ai)
#pragma unroll
            for (int m = 0; m < 4; ++m) {
                bf16_t* rowp = nt_blk ? O + (((size_t)u.pm * nt_blk + (col0 >> 6)) * 2 + ai) * (HALF * BK) + (lds_byte(wr * 64 + fr + m * 16, col0 & 63) >> 1)
                                      : O + (size_t)(row0 + ai * HALF + m * 16) * ldc + col0;
                const float rs = (ssq ? rsqrtf(ssq[row0 + ai * HALF + m * 16] * (1.f / 2048.f) + 1e-6f) : 1.f) * oscale;
                const float nrl = -1.4426950408889634f * rs, rs2 = rs * rs;
                u32x4 w;
#pragma unroll
                for (int n = 0; n < 2; ++n)
#pragma unroll
                    for (int hh = 0; hh < 2; ++hh) {
                        const f32x2 g = {acc[ai][0][m][n][2 * hh], acc[ai][0][m][n][2 * hh + 1]}, uu = {acc[ai][1][m][n][2 * hh], acc[ai][1][m][n][2 * hh + 1]};
                        const f32x2 t = g * nrl; f32x2 ex; ex.x = __builtin_amdgcn_exp2f(t.x); ex.y = __builtin_amdgcn_exp2f(t.y);
                        const f32x2 d = ex + 1.0f; f32x2 r; r.x = __builtin_amdgcn_rcpf(d.x); r.y = __builtin_amdgcn_rcpf(d.y);
                        const f32x2 o = (g * uu) * (r * rs2);
                        w[2 * n + hh] = cvt_pk_bf16(o.x, o.y);
                    }
                __builtin_nontemporal_store(w, (u32x4*)rowp);
            }
    }
};
struct EpiResid {
    static constexpr bool PERM = false, AFTER_DRAIN = false, MIDHOOK = false;
    const float* base; float* out; float scale;
    __device__ __forceinline__ void operator()(const f32x4 (&acc)[2][2][4][2], const Unit& u, int wr, int wc, int fr, int fq) const {
        const int col0 = u.pn * BM + wc * 32 + 4 * fq;
#pragma unroll
        for (int ai = 0; ai < 2; ++ai)
#pragma unroll
            for (int m = 0; m < 4; ++m) { const size_t off = (size_t)(u.pm * BM + ai * HALF + wr * 64 + m * 16 + fr) * 2048 + col0;
#pragma unroll
                for (int bj = 0; bj < 2; ++bj)
#pragma unroll
                    for (int n = 0; n < 2; ++n) { const f32x4 bs = *(const f32x4*)(base + off + bj * HALF + n * 16); *(f32x4*)(out + off + bj * HALF + n * 16) = bs + acc[ai][bj][m][n] * scale; } }
    }
};
struct EpiQK {
    static constexpr bool PERM = true, AFTER_DRAIN = false, MIDHOOK = false;
    bf16_t* Q; bf16_t* KF; float qscale; const float* ssq;
    __device__ __forceinline__ void operator()(const f32x4 (&acc)[2][2][4][2], const Unit& u, int wr, int wc, int fr, int fq) const {
        const int row0 = u.pm * BM + wr * 64 + fr;
        if (u.pn < 8) {
            const int col0 = u.pn * BM + wc * 32 + 8 * fq;
#pragma unroll
            for (int ai = 0; ai < 2; ++ai)
#pragma unroll
                for (int m = 0; m < 4; ++m) { bf16_t* rowp = Q + (size_t)(row0 + ai * HALF + m * 16) * 2048 + col0; const float rs = qscale * rsqrtf(ssq[row0 + ai * HALF + m * 16] * (1.f / 2048.f) + 1e-6f);
#pragma unroll
                    for (int bj = 0; bj < 2; ++bj) { const f32x4 v0 = acc[ai][bj][m][0] * rs, v1 = acc[ai][bj][m][1] * rs;
                        u32x4 w; w.x = cvt_pk_bf16(v0[0], v0[1]); w.y = cvt_pk_bf16(v0[2], v0[3]); w.z = cvt_pk_bf16(v1[0], v1[1]); w.w = cvt_pk_bf16(v1[2], v1[3]);
                        *(u32x4*)(rowp + bj * HALF) = w; } }
        } else {
#pragma unroll
            for (int bj = 0; bj < 2; ++bj) {
                const int kcol = (u.pn - 8) * BM + bj * HALF + wc * 32 + 8 * fq, kh = kcol >> 6, chunk = (kcol & 63) >> 3;
#pragma unroll
                for (int ai = 0; ai < 2; ++ai)
#pragma unroll
                    for (int m = 0; m < 4; ++m) { const int r = row0 + ai * HALF + m * 16, b = r >> 11, t = r & 2047;
                        bf16_t* p = KF + (size_t)(b * 20 + kh) * 131072 + (size_t)((t >> 5) * 8 + chunk) * 256 + (t & 31) * 8;
                        const float rs = rsqrtf(ssq[r] * (1.f / 2048.f) + 1e-6f);
                        const f32x4 v0 = acc[ai][bj][m][0] * rs, v1 = acc[ai][bj][m][1] * rs;
                        u32x4 w; w.x = cvt_pk_bf16(v0[0], v0[1]); w.y = cvt_pk_bf16(v0[2], v0[3]); w.z = cvt_pk_bf16(v1[0], v1[1]); w.w = cvt_pk_bf16(v1[2], v1[3]);
                        *(u32x4*)p = w; }
            }
        }
    }
};
struct EpiVT {
    static constexpr bool PERM = true, AFTER_DRAIN = false, MIDHOOK = false;
    bf16_t* VF; const float* ssq;
    __device__ __forceinline__ void operator()(const f32x4 (&acc)[2][2][4][2], const Unit& u, int wr, int wc, int fr, int fq) const {
#pragma unroll
        for (int bj = 0; bj < 2; ++bj) {
            const int tok = u.pn * BM + bj * HALF + wc * 32 + 8 * fq, b = tok >> 11, t = tok & 2047, g = t >> 4, ih = (t & 15) >> 3;
            f32x4 rs0 = *(const f32x4*)(ssq + tok), rs1 = *(const f32x4*)(ssq + tok + 4);
#pragma unroll
            for (int e_ = 0; e_ < 4; ++e_) { rs0[e_] = rsqrtf(rs0[e_] * (1.f / 2048.f) + 1e-6f); rs1[e_] = rsqrtf(rs1[e_] * (1.f / 2048.f) + 1e-6f); }
#pragma unroll
            for (int ai = 0; ai < 2; ++ai)
#pragma unroll
                for (int m = 0; m < 4; ++m) { const int r = u.pm * BM + ai * HALF + wr * 64 + m * 16 + fr, vh = r >> 6, d = r & 63, d0 = d >> 5, dl = d & 31;
                    bf16_t* p = VF + (size_t)(b * 20 + vh) * 131072 + (size_t)((g * 2 + d0) * 2) * 256 + dl * 8 + ih * 4;
                    const f32x4 v0 = acc[ai][bj][m][0] * rs0, v1 = acc[ai][bj][m][1] * rs1;
                    u32x2 w0, w1; w0.x = cvt_pk_bf16(v0[0], v0[1]); w0.y = cvt_pk_bf16(v0[2], v0[3]); w1.x = cvt_pk_bf16(v1[0], v1[1]); w1.y = cvt_pk_bf16(v1[2], v1[3]);
                    *(u32x2*)p = w0;
                    *(u32x2*)(p + 256) = w1; }
        }
    }
};

struct InProjOrder {
    StaticOrder qk, vt; int nqk, ntot, G, c; const bf16_t* X; const bf16_t* Wqk; const bf16_t* Wv;
    __device__ void init(int M, int NQK_, int NVT_, int G_, int c_, const bf16_t* X_, const bf16_t* W_, int K) {
        qk.init(M, NQK_, G_, c_); vt.init(NVT_, M, G_, c_); nqk = qk.nwg; ntot = qk.nwg + vt.nwg; G = G_; c = c_; X = X_; Wqk = W_; Wv = W_ + (size_t)NQK_ * K; }
    __device__ bool next(int i, Unit& u) const { const long L = (long)i * G + c; if (L >= ntot) return false;
        if (L < nqk) { u.ty = 0; qk.map((int)L, u); } else { u.ty = 1; vt.map((int)L - nqk, u); } return true; }
    __device__ __forceinline__ const char* pa(const Gemm&, const Unit& u, size_t tstep) const { return (const char*)(u.ty ? Wv : X) + (size_t)u.pm * tstep; }
    __device__ __forceinline__ const char* pb(const Gemm&, const Unit& u, size_t tstep) const { return (const char*)(u.ty ? X : Wqk) + (size_t)u.pn * tstep; }
    __device__ __forceinline__ void a_ready(const Unit&) const {}
    __device__ __forceinline__ void done(const Unit&) const {}
};
struct EpiInProj {
    static constexpr bool PERM = true, AFTER_DRAIN = false, MIDHOOK = false;
    EpiQK qk; EpiVT vt;
    __device__ __forceinline__ void operator()(const f32x4 (&acc)[2][2][4][2], const Unit& u, int wr, int wc, int fr, int fq) const { if (u.ty == 0) qk(acc, u, wr, wc, fr, fq); else vt(acc, u, wr, wc, fr, fq); }
};

template <bool MID, bool BASE16, bool F32OUT, bool W16, bool W8> struct EpiResidStat {
    static constexpr bool PERM = true, AFTER_DRAIN = false, MIDHOOK = MID;
    const void* base; float* out; bf16_t* xb16; unsigned char* xb8; float* ssq; float scale; const float* ssqy;
    __device__ __forceinline__ void mid(f32x4 (&acc)[2][2][4][2], const Unit& u, int wr, int wc, int fr, int fq) const {
#pragma unroll
        for (int ai = 0; ai < 2; ++ai)
#pragma unroll
            for (int m = 0; m < 4; ++m) { const int r = u.pm * BM + ai * HALF + wr * 64 + m * 16 + fr; const f32x2 sy = *(const f32x2*)(ssqy + 2 * r);
                const float ratio = rsqrtf(sy.x * (1.f / 1024.f) + 1e-6f) * sqrtf(sy.y * (1.f / 1024.f) + 1e-6f);
#pragma unroll
                for (int bj = 0; bj < 2; ++bj)
#pragma unroll
                    for (int n = 0; n < 2; ++n) acc[ai][bj][m][n] *= ratio; }
    }
    __device__ __forceinline__ void operator()(const f32x4 (&acc)[2][2][4][2], const Unit& u, int wr, int wc, int fr, int fq) const {
        const int col0 = u.pn * BM + wc * 32 + 8 * fq;
#pragma unroll
        for (int ai = 0; ai < 2; ++ai) {
            u32x4 b16[4][2]; f32x4 b32[4][2][2]; float sy[4];
#pragma unroll
            for (int m = 0; m < 4; ++m) { const int r = u.pm * BM + ai * HALF + wr * 64 + m * 16 + fr; const size_t off = (size_t)r * 2048 + col0;
                if (MID) sy[m] = ssqy[2 * r + 1];
#pragma unroll
                for (int bj = 0; bj < 2; ++bj) { const size_t o = off + bj * HALF;
                    if constexpr (BASE16) b16[m][bj] = __builtin_nontemporal_load((const u32x4*)((const bf16_t*)base + o));
                    else { b32[m][bj][0] = __builtin_nontemporal_load((const f32x4*)((const float*)base + o)); b32[m][bj][1] = __builtin_nontemporal_load((const f32x4*)((const float*)base + o + 4)); } } }
#pragma unroll
            for (int m = 0; m < 4; ++m) { const int r = u.pm * BM + ai * HALF + wr * 64 + m * 16 + fr; const size_t off = (size_t)r * 2048 + col0;
                float sc = scale; if (MID) sc *= rsqrtf(sy[m] * (1.f / 1024.f) + 1e-6f);
                float s = 0.f;
#pragma unroll
                for (int bj = 0; bj < 2; ++bj) { const size_t o = off + bj * HALF;
                    f32x4 bs0, bs1;
                    if constexpr (BASE16) { const u32x4 bw = b16[m][bj];
                        bs0 = (f32x4){__uint_as_float(bw.x << 16), __uint_as_float(bw.x & 0xffff0000u), __uint_as_float(bw.y << 16), __uint_as_float(bw.y & 0xffff0000u)};
                        bs1 = (f32x4){__uint_as_float(bw.z << 16), __uint_as_float(bw.z & 0xffff0000u), __uint_as_float(bw.w << 16), __uint_as_float(bw.w & 0xffff0000u)}; }
                    else { bs0 = b32[m][bj][0]; bs1 = b32[m][bj][1]; }
                    const f32x4 v0 = bs0 + acc[ai][bj][m][0] * sc, v1 = bs1 + acc[ai][bj][m][1] * sc;
                    if constexpr (F32OUT) { *(f32x4*)(out + o) = v0; *(f32x4*)(out + o + 4) = v1; }
                    s += ((v0[0] * v0[0] + v0[1] * v0[1]) + (v0[2] * v0[2] + v0[3] * v0[3])) + ((v1[0] * v1[0] + v1[1] * v1[1]) + (v1[2] * v1[2] + v1[3] * v1[3]));
                    if constexpr (W16) { u32x4 w; w.x = cvt_pk_bf16(v0[0], v0[1]); w.y = cvt_pk_bf16(v0[2], v0[3]); w.z = cvt_pk_bf16(v1[0], v1[1]); w.w = cvt_pk_bf16(v1[2], v1[3]); *(u32x4*)(xb16 + o) = w; }
                    if constexpr (W8) { u32x2 w; w.x = pk4_fp8(v0[0], v0[1], v0[2], v0[3]); w.y = pk4_fp8(v1[0], v1[1], v1[2], v1[3]); *(u32x2*)(xb8 + o) = w; } }
                s += __shfl_xor(s, 16); s += __shfl_xor(s, 32);
                if (fq == 0) __hip_atomic_fetch_add(ssq + r, s, __ATOMIC_RELAXED, __HIP_MEMORY_SCOPE_AGENT); }
            asm volatile("" ::: "memory");
        }
    }
};
template <bool F> struct Frags { bf16x8 At[4][2], B0[2][2], B1[2][2]; };
template <> struct Frags<true> { i32x8 At[4], B0[2], B1[2]; };
template <class Epi, class Sched, bool ALIGN_EPI = false, bool SP2 = false, bool FP8 = false>
__device__ __forceinline__ void gemm_phase(PG8_LAS unsigned char* lds, const Gemm g, const Sched& S, const Epi& E, const int wave_s  ) {
    const int tid_ = wave_s * 64 + lane_id();
    const int tid = tid_, wid = wave_s, lane = tid & 63, wr = wid >> 2, wc = wid & 3, fr = lane & 15, fq = lane >> 4;
    const int K = g.K, nt = K / BK, LD = g.blk ? BK : g.ld;
    unsigned voffA[2], voffB[2];
#pragma unroll
    for (int i = 0; i < 2; ++i) { int R, C; stage_rc(tid * 16 + i * 8192, R, C); const int Rb = Epi::PERM ? ((R & ~31) + perm32(R & 31)) : R;
        voffA[i] = (unsigned)(R * LD + C) * 2u; voffB[i] = (unsigned)(Rb * LD + C) * 2u;
        if (g.blk == 2) { voffA[i] = (unsigned)(tid * 16 + i * 8192); voffB[i] = voffA[i]; } }
    const size_t kstep = g.blk ? (size_t)BM * BK * 2 : (size_t)(BK * 2);
    const size_t hstep = (size_t)HALF * LD * 2;
    const size_t tstep = g.blk ? (size_t)nt * BM * BK * 2 : 2 * hstep;
    const unsigned ldsw = (unsigned)wid * 1024u;
    const int aoff = lds_byte(wr * 64 + fr, fq * 8), boff = lds_byte(wc * 32 + fr, fq * 8);
#define PG8_SA(b, h) (((b) * 2 + (h)) * HTB)
#define PG8_SB(b, h) ((4 + (b) * 2 + (h)) * HTB)
#define PG8_STAGE(bufoff, gbase, voff) do { _Pragma("unroll") for (int _i = 0; _i < 2; ++_i) \
        __builtin_amdgcn_global_load_lds((const unsigned*)((const char*)(gbase) + (voff)[_i]), (PG8_LAS unsigned*)(lds + (bufoff) + ldsw + _i * 8192), 16, 0, 0); } while (0)
#define PG8_LDA(dst, b, h) do { if constexpr (FP8) { _Pragma("unroll") for (int m = 0; m < 4; ++m) dst[m] = __builtin_shufflevector(*(const PG8_LAS i32x4*)(lds + PG8_SA(b, h) + aoff + m * 2048), *(const PG8_LAS i32x4*)(lds + PG8_SA(b, h) + aoff + m * 2048 + 1024), 0, 1, 2, 3, 4, 5, 6, 7); } \
    else { _Pragma("unroll") for (int m = 0; m < 4; ++m) _Pragma("unroll") for (int k = 0; k < 2; ++k) dst[m][k] = *(const PG8_LAS bf16x8*)(lds + PG8_SA(b, h) + aoff + m * 2048 + k * 1024); } } while (0)
#define PG8_LDB(dst, b, h) do { if constexpr (FP8) { _Pragma("unroll") for (int n = 0; n < 2; ++n) dst[n] = __builtin_shufflevector(*(const PG8_LAS i32x4*)(lds + PG8_SB(b, h) + boff + n * 2048), *(const PG8_LAS i32x4*)(lds + PG8_SB(b, h) + boff + n * 2048 + 1024), 0, 1, 2, 3, 4, 5, 6, 7); } \
    else { _Pragma("unroll") for (int n = 0; n < 2; ++n) _Pragma("unroll") for (int k = 0; k < 2; ++k) dst[n][k] = *(const PG8_LAS bf16x8*)(lds + PG8_SB(b, h) + boff + n * 2048 + k * 1024); } } while (0)
#define PG8_CAT(x) __builtin_shufflevector(__builtin_bit_cast(i32x4, (x)[0]), __builtin_bit_cast(i32x4, (x)[1]), 0, 1, 2, 3, 4, 5, 6, 7)
#define PG8_MMA(ai, bj, At, Bt) do { __builtin_amdgcn_s_setprio(1); if constexpr (FP8) { _Pragma("unroll") for (int m = 0; m < 4; ++m) _Pragma("unroll") for (int n = 0; n < 2; ++n) \
        asm volatile("v_mfma_f32_16x16x128_f8f6f4 %0, %1, %2, %0" : "+v"(acc[ai][bj][m][n]) : "v"(Bt[n]), "v"(At[m])); } else { \
        _Pragma("unroll") for (int m = 0; m < 4; ++m) _Pragma("unroll") for (int n = 0; n < 2; ++n) _Pragma("unroll") for (int k = 0; k < 2; ++k) \
        acc[ai][bj][m][n] = __builtin_amdgcn_mfma_f32_16x16x32_bf16(Bt[n][k], At[m][k], acc[ai][bj][m][n], 0, 0, 0); } __builtin_amdgcn_s_setprio(0); } while (0)
#define PG8_WAIT_V(n) asm volatile("s_waitcnt vmcnt(" #n ")" ::: "memory")
#define PG8_WAIT_L(n) asm volatile("s_waitcnt lgkmcnt(" #n ")" ::: "memory")
#define PG8_BAR __builtin_amdgcn_s_barrier()
#define PG8_SCHED __builtin_amdgcn_sched_barrier(0)
    Unit cur, nxt; int ui = 0;
    if (!S.next(0, cur)) return;
    f32x4 acc[2][2][4][2];
#pragma unroll
    for (int a = 0; a < 2; ++a)
#pragma unroll
        for (int b = 0; b < 2; ++b)
#pragma unroll
            for (int m = 0; m < 4; ++m)
#pragma unroll
                for (int n = 0; n < 2; ++n) acc[a][b][m][n] = (f32x4){0.f, 0.f, 0.f, 0.f};
    Frags<FP8> frg_; auto& At = frg_.At; auto& B0 = frg_.B0; auto& B1 = frg_.B1;
    const char* cA = S.pa(g, cur, tstep); const char* cB = S.pb(g, cur, tstep);
    S.a_ready(cur);
    if constexpr (SP2) {
        PG8_STAGE(PG8_SB(0, 0), cB, voffB); PG8_STAGE(PG8_SB(0, 1), cB + hstep, voffB); PG8_STAGE(PG8_SA(0, 0), cA, voffA); PG8_STAGE(PG8_SA(0, 1), cA + hstep, voffA);
        if (wr == 1) PG8_BAR;
        PG8_WAIT_V(2); PG8_BAR;
        PG8_STAGE(PG8_SB(1, 0), cB + kstep, voffB); PG8_STAGE(PG8_SA(1, 0), cA + kstep, voffA); PG8_STAGE(PG8_SB(1, 1), cB + hstep + kstep, voffB);
        PG8_WAIT_V(6); PG8_BAR;
    } else {
        PG8_STAGE(PG8_SB(0, 0), cB, voffB); PG8_STAGE(PG8_SA(0, 0), cA, voffA); PG8_STAGE(PG8_SB(0, 1), cB + hstep, voffB); PG8_STAGE(PG8_SA(0, 1), cA + hstep, voffA);
        if (wr == 1) PG8_BAR;
        PG8_WAIT_V(4); PG8_BAR;
        PG8_STAGE(PG8_SB(1, 0), cB + kstep, voffB); PG8_STAGE(PG8_SA(1, 0), cA + kstep, voffA); PG8_STAGE(PG8_SB(1, 1), cB + hstep + kstep, voffB);
        PG8_WAIT_V(6); PG8_BAR;
    }
    for (;;) {
        const bool has_next = S.next(ui + 1, nxt);
        const char* nA = has_next ? S.pa(g, nxt, tstep) : cA; const char* nB = has_next ? S.pb(g, nxt, tstep) : cB;
        for (int t = 0; t < nt; t += 2) {
            if constexpr (Epi::MIDHOOK) { if (t == (nt >> 1)) E.mid(acc, cur, wr, wc, fr, fq); }
            const bool last = (t == nt - 2);
            const char* a1 = cA + (size_t)(t + 1) * kstep;
            const char* a2 = last ? nA : cA + (size_t)(t + 2) * kstep; const char* b2 = last ? nB : cB + (size_t)(t + 2) * kstep;
            const char* a3 = a2 + kstep; const char* b3 = b2 + kstep;
            if (last && has_next) S.a_ready(nxt);
            if constexpr (SP2) {
            PG8_LDB(B0, 0, 0); PG8_LDB(B1, 0, 1); PG8_SCHED; PG8_LDA(At, 0, 0); PG8_STAGE(PG8_SA(1, 1), a1 + hstep, voffA);
            PG8_WAIT_V(8); PG8_WAIT_L(0); PG8_BAR; PG8_MMA(0, 0, At, B0); PG8_MMA(0, 1, At, B1); PG8_BAR; PG8_SCHED;
            PG8_LDA(At, 0, 1); PG8_STAGE(PG8_SB(0, 0), b2, voffB); PG8_STAGE(PG8_SB(0, 1), b2 + hstep, voffB); PG8_STAGE(PG8_SA(0, 0), a2, voffA);
            PG8_WAIT_V(8); PG8_WAIT_L(0); PG8_BAR; PG8_MMA(1, 0, At, B0); PG8_MMA(1, 1, At, B1); PG8_BAR; PG8_SCHED;
            PG8_LDB(B0, 1, 0); PG8_LDB(B1, 1, 1); PG8_SCHED; PG8_LDA(At, 1, 0); PG8_STAGE(PG8_SA(0, 1), a2 + hstep, voffA);
            PG8_WAIT_V(8); PG8_WAIT_L(0); PG8_BAR; PG8_MMA(0, 0, At, B0); PG8_MMA(0, 1, At, B1); PG8_BAR; PG8_SCHED;
            PG8_LDA(At, 1, 1); PG8_STAGE(PG8_SB(1, 0), b3, voffB); PG8_STAGE(PG8_SB(1, 1), b3 + hstep, voffB); PG8_STAGE(PG8_SA(1, 0), a3, voffA);
            PG8_WAIT_V(8); PG8_WAIT_L(0); PG8_BAR; PG8_MMA(1, 0, At, B0); PG8_MMA(1, 1, At, B1); PG8_BAR; PG8_SCHED;
            } else {
            PG8_LDB(B0, 0, 0); PG8_SCHED; PG8_LDA(At, 0, 0); PG8_STAGE(PG8_SA(1, 1), a1 + hstep, voffA);
            PG8_WAIT_L(8); PG8_BAR; PG8_WAIT_L(0); PG8_MMA(0, 0, At, B0); PG8_BAR; PG8_SCHED;
            PG8_LDB(B1, 0, 1); PG8_STAGE(PG8_SB(0, 0), b2, voffB);
            PG8_BAR; PG8_WAIT_L(0); PG8_MMA(0, 1, At, B1); PG8_BAR;
            PG8_LDA(At, 0, 1); PG8_STAGE(PG8_SA(0, 0), a2, voffA);
            PG8_BAR; PG8_WAIT_L(0); PG8_MMA(1, 0, At, B0); PG8_BAR; PG8_SCHED;
            PG8_STAGE(PG8_SB(0, 1), b2 + hstep, voffB);
            PG8_WAIT_V(6); PG8_BAR; PG8_MMA(1, 1, At, B1); PG8_BAR;
            PG8_LDB(B0, 1, 0); PG8_SCHED; PG8_LDA(At, 1, 0); PG8_STAGE(PG8_SA(0, 1), a2 + hstep, voffA);
            PG8_WAIT_L(8); PG8_BAR; PG8_WAIT_L(0); PG8_MMA(0, 0, At, B0); PG8_BAR; PG8_SCHED;
            PG8_LDB(B1, 1, 1); PG8_STAGE(PG8_SB(1, 0), b3, voffB);
            PG8_BAR; PG8_WAIT_L(0); PG8_MMA(0, 1, At, B1); PG8_BAR;
            PG8_LDA(At, 1, 1); PG8_STAGE(PG8_SA(1, 0), a3, voffA);
            PG8_BAR; PG8_WAIT_L(0); PG8_MMA(1, 0, At, B0); PG8_BAR; PG8_SCHED;
            PG8_STAGE(PG8_SB(1, 1), b3 + hstep, voffB);
            PG8_WAIT_V(6); PG8_BAR; PG8_MMA(1, 1, At, B1); PG8_BAR;
            }
        }
        if constexpr (FP8) { asm volatile("s_nop 15\n\ts_nop 15" ::: "memory"); }
        if constexpr (ALIGN_EPI) { if (wr == 0) PG8_BAR; }
        if constexpr (!Epi::AFTER_DRAIN) { E(acc, cur, wr, wc, fr, fq); S.done(cur); }
        if (!has_next) break;
#pragma unroll
        for (int a = 0; a < 2; ++a)
#pragma unroll
            for (int b = 0; b < 2; ++b)
#pragma unroll
                for (int m = 0; m < 4; ++m)
#pragma unroll
                    for (int n = 0; n < 2; ++n) acc[a][b][m][n] = (f32x4){0.f, 0.f, 0.f, 0.f};
        cur = nxt; cA = nA; cB = nB; ++ui;
        if constexpr (ALIGN_EPI) { if (wr == 1) PG8_BAR; }
    }
    PG8_WAIT_V(0);
    if constexpr (!ALIGN_EPI) { if (wr == 0) PG8_BAR; }
    PG8_BAR;
    if constexpr (Epi::AFTER_DRAIN) { E.fused(acc, cur, wr, wc, fr, fq, lds, wid, lane); S.done(cur); }
#undef PG8_SA
#undef PG8_SB
#undef PG8_STAGE
#undef PG8_LDA
#undef PG8_LDB
#undef PG8_MMA
#undef PG8_CAT
#undef PG8_WAIT_V
#undef PG8_WAIT_L
#undef PG8_BAR
#undef PG8_SCHED
}
}
#define LAS __attribute__((address_space(3)))
typedef unsigned short bf16_t;
typedef short bf16x8 __attribute__((ext_vector_type(8)));
typedef float f32x2 __attribute__((ext_vector_type(2)));
typedef float f32x4 __attribute__((ext_vector_type(4)));
typedef float f32x16 __attribute__((ext_vector_type(16)));
typedef unsigned u32x2 __attribute__((ext_vector_type(2)));
typedef unsigned u32x4 __attribute__((ext_vector_type(4)));
constexpr int DM = 2048, SEQ = 2048, NBATCH = 16, MTOK = NBATCH * SEQ, DFF = 5504, NKVH = 20;
constexpr int NQK = 3328;
constexpr int NVT = 1280;
constexpr int LDH = 5568;
constexpr float EPS = 1e-6f;
constexpr float LOG2E = 1.4426950408889634f;
constexpr float QSCALE = 0.125f * LOG2E;
constexpr int NWAVES = 8;
constexpr int LDS_STAGE = 131072, LDS_BYTES = LDS_STAGE + 256;
constexpr size_t MiB = 1u << 20;
constexpr size_t WS_WGU1 = 0, WS_WD1 = 43 * MiB, WS_WIN = WS_WD1 + 22 * MiB, WS_WOUT = WS_WIN + 18 * MiB, WS_WGU2 = WS_WOUT + 8 * MiB, WS_WD2 = WS_WGU2 + 43 * MiB;
constexpr size_t WS_HN = 156 * MiB;
constexpr size_t WS_H = 284 * MiB;
constexpr size_t WS_Q = WS_H, WS_KF = WS_H + 128 * MiB, WS_VF = WS_H + 208 * MiB;
constexpr size_t WS_Y = 636 * MiB;
constexpr size_t WS_SSQ = 764 * MiB;
constexpr size_t WS_CTL = 765 * MiB, CTL_BYTES = 16384;
constexpr size_t WS_X2F8 = 768 * MiB;
constexpr size_t WS_X2B = 832 * MiB;
constexpr size_t WS_END = 960 * MiB;
static_assert(WS_H + (size_t)MTOK * LDH * 2 <= WS_Y, "H fits");
static_assert(WS_WD2 + 22 * MiB <= WS_HN && (size_t)2048 * LDH * 2 <= 22 * MiB, "weights fit");

__device__ __forceinline__ unsigned pk2(float lo, float hi) { unsigned r; asm volatile("v_cvt_pk_bf16_f32 %0, %1, %2" : "=v"(r) : "v"(lo), "v"(hi)); return r; }
__device__ __forceinline__ float bf_lo(unsigned w) { return __uint_as_float(w << 16); }
__device__ __forceinline__ float bf_hi(unsigned w) { return __uint_as_float(w & 0xffff0000u); }
__device__ __forceinline__ float wave_sum(float v) {
#pragma unroll
    for (int o = 1; o < 64; o <<= 1) v += __shfl_xor(v, o);
    return v;
}

__device__ __forceinline__ int dest_row0(int type, int n0) {
    if (type == 0) return n0;
    if (type == 1) return (n0 >> 7) * 256;
    if (type == 2) return (n0 >> 7) * 256 + 128;
    if (n0 < 1024) return n0;
    if (n0 < 1280) return 2048 + (n0 - 1024);
    if (n0 < 1536) return 3328 + (n0 - 1280);
    if (n0 < 2560) return 1024 + (n0 - 1536);
    if (n0 < 3584) return 2304 + (n0 - 2560);
    return n0;
}
__device__ __forceinline__ unsigned pk4_fp8w(float a, float b, float c, float d) {
    a = fminf(fmaxf(a, -448.f), 448.f); b = fminf(fmaxf(b, -448.f), 448.f); c = fminf(fmaxf(c, -448.f), 448.f); d = fminf(fmaxf(d, -448.f), 448.f);
    unsigned w = 0; w = __builtin_amdgcn_cvt_pk_fp8_f32(a, b, w, false); w = __builtin_amdgcn_cvt_pk_fp8_f32(c, d, w, true); return w; }
constexpr float W8_SCALE = 256.f;
template <bool FP8 = false> __device__ __forceinline__ void transpose_item(const float* __restrict__ W, int K, int N, bf16_t* __restrict__ WT, int type, int item, int lane, const float* __restrict__ gk = nullptr, const float* __restrict__ gk2 = nullptr, int ldk = 0, int blk_nt = 0) {
    if (ldk == 0) ldk = K;
    const int nkc = K >> 6, nb = item / nkc, kc = item - nb * nkc, n0 = nb * 128, k0 = kc * 64;
    const int drow = dest_row0(type, n0) + 2 * lane;
    const float* src = W + (size_t)k0 * N + n0 + 2 * lane;
    bf16_t* d0 = WT + (size_t)drow * ldk + k0;
    int img_off1 = 0;
    if (blk_nt) {
        const int rl = drow & 255, pos = (rl & ~31) + pg8::invperm32(rl & 31);
        d0 = WT + (((size_t)(drow >> 8) * blk_nt + kc) * 2 + (pos >> 7)) * 8192; ldk = 0;
        img_off1 = pos & 127; }
#pragma unroll 2
    for (int kb = 0; kb < 8; ++kb) {
        f32x2 v[8];
#pragma unroll
        for (int i = 0; i < 8; ++i) v[i] = __builtin_nontemporal_load((const f32x2*)(src + (size_t)(kb * 8 + i) * N));
        if (gk) {
            const float* gp = (gk2 && k0 >= 1024) ? gk2 + (k0 - 1024) + kb * 8 : gk + k0 + kb * 8;
#pragma unroll
            for (int i = 0; i < 8; ++i) v[i] *= gp[i];
        }
        if constexpr (FP8) {
            u32x2 a, b;
            a.x = pk4_fp8w(v[0].x * W8_SCALE, v[1].x * W8_SCALE, v[2].x * W8_SCALE, v[3].x * W8_SCALE); a.y = pk4_fp8w(v[4].x * W8_SCALE, v[5].x * W8_SCALE, v[6].x * W8_SCALE, v[7].x * W8_SCALE);
            b.x = pk4_fp8w(v[0].y * W8_SCALE, v[1].y * W8_SCALE, v[2].y * W8_SCALE, v[3].y * W8_SCALE); b.y = pk4_fp8w(v[4].y * W8_SCALE, v[5].y * W8_SCALE, v[6].y * W8_SCALE, v[7].y * W8_SCALE);
            unsigned char* d8 = (unsigned char*)WT + (size_t)drow * ldk + k0 + kb * 8;
            *(u32x2*)d8 = a; *(u32x2*)(d8 + ldk) = b;
            continue;
        }
        u32x4 a, b;
        a.x = pk2(v[0].x, v[1].x); a.y = pk2(v[2].x, v[3].x); a.z = pk2(v[4].x, v[5].x); a.w = pk2(v[6].x, v[7].x);
        b.x = pk2(v[0].y, v[1].y); b.y = pk2(v[2].y, v[3].y); b.z = pk2(v[4].y, v[5].y); b.w = pk2(v[6].y, v[7].y);
        if (blk_nt) { *(u32x4*)(d0 + (pg8::lds_byte(img_off1, kb * 8) >> 1)) = a; *(u32x4*)(d0 + (pg8::lds_byte(img_off1 + 1, kb * 8) >> 1)) = b; }
        else { *(u32x4*)(d0 + kb * 8) = a; *(u32x4*)(d0 + ldk + kb * 8) = b; }
    }
}
__device__ __forceinline__ void rms_row_bf16(const float* xrow, const float* __restrict__ g, bf16_t* orow, int lane) {
    const f32x4* xr = (const f32x4*)xrow + lane;
    f32x4 v[8]; float s = 0.f;
#pragma unroll
    for (int j = 0; j < 8; ++j) { v[j] = __builtin_nontemporal_load(xr + 64 * j); s += (v[j].x * v[j].x + v[j].y * v[j].y) + (v[j].z * v[j].z + v[j].w * v[j].w); }
    const float rstd = rsqrtf(wave_sum(s) * (1.f / DM) + EPS);
    u32x2* o8 = (u32x2*)orow + lane;
#pragma unroll
    for (int j = 0; j < 8; ++j) { const f32x4 gv = ((const f32x4*)g)[lane + 64 * j]; u32x2 w; w.x = pk2(v[j].x * rstd * gv.x, v[j].y * rstd * gv.y); w.y = pk2(v[j].z * rstd * gv.z, v[j].w * rstd * gv.w); o8[64 * j] = w; }
}
__device__ __forceinline__ void rms_row_f32(float* xrow, const float* __restrict__ g, int lane) {
    f32x4* xr = (f32x4*)xrow + lane;
    f32x4 v[8]; float s = 0.f;
#pragma unroll
    for (int j = 0; j < 8; ++j) { v[j] = xr[64 * j]; s += (v[j].x * v[j].x + v[j].y * v[j].y) + (v[j].z * v[j].z + v[j].w * v[j].w); }
    const float rstd = rsqrtf(wave_sum(s) * (1.f / DM) + EPS);
#pragma unroll
    for (int j = 0; j < 8; ++j) { const f32x4 gv = ((const f32x4*)g)[lane + 64 * j]; xr[64 * j] = v[j] * rstd * gv; }
}
__device__ __forceinline__ void final_row(const bf16_t* xrow, float ssq, const float* __restrict__ g, float* orow, int lane) {
    const float rstd = rsqrtf(ssq * (1.f / DM) + EPS);
#pragma unroll
    for (int j = 0; j < 4; ++j) { const u32x4 w = ((const u32x4*)xrow)[lane + 64 * j]; const float* gp = g + (lane + 64 * j) * 8; const f32x4 g0 = *(const f32x4*)gp, g1 = *(const f32x4*)(gp + 4);
        f32x4 o0, o1; o0.x = bf_lo(w.x) * rstd * g0.x; o0.y = bf_hi(w.x) * rstd * g0.y; o0.z = bf_lo(w.y) * rstd * g0.z; o0.w = bf_hi(w.y) * rstd * g0.w;
        o1.x = bf_lo(w.z) * rstd * g1.x; o1.y = bf_hi(w.z) * rstd * g1.y; o1.z = bf_lo(w.w) * rstd * g1.z; o1.w = bf_hi(w.w) * rstd * g1.w;
        float* op = orow + (lane + 64 * j) * 8; __builtin_nontemporal_store(o0, (f32x4*)op); __builtin_nontemporal_store(o1, (f32x4*)(op + 4)); }
}
__device__ __forceinline__ void group_norm_row(const bf16_t* yrow, const float* __restrict__ ga, const float* __restrict__ gb, bf16_t* orow, int lane) {
    u32x4 w[4]; float sa = 0.f, sb = 0.f;
#pragma unroll
    for (int j = 0; j < 4; ++j) { w[j] = ((const u32x4*)yrow)[lane + 64 * j]; float s = 0.f;
#pragma unroll
        for (int e = 0; e < 4; ++e) { const float a = bf_lo(w[j][e]), b = bf_hi(w[j][e]); s += a * a + b * b; }
        if (j < 2) sa += s; else sb += s; }
    const float ra = rsqrtf(wave_sum(sa) * (1.f / 1024.f) + EPS), rb = rsqrtf(wave_sum(sb) * (1.f / 1024.f) + EPS);
#pragma unroll
    for (int j = 0; j < 4; ++j) { const float* g = (j < 2 ? ga : gb) + (j & 1) * 512 + lane * 8; const float r = j < 2 ? ra : rb;
        const f32x4 g0 = *(const f32x4*)g, g1 = *(const f32x4*)(g + 4); u32x4 o;
        o.x = pk2(bf_lo(w[j].x) * r * g0.x, bf_hi(w[j].x) * r * g0.y); o.y = pk2(bf_lo(w[j].y) * r * g0.z, bf_hi(w[j].y) * r * g0.w);
        o.z = pk2(bf_lo(w[j].z) * r * g1.x, bf_hi(w[j].z) * r * g1.y); o.w = pk2(bf_lo(w[j].w) * r * g1.z, bf_hi(w[j].w) * r * g1.w);
        ((u32x4*)orow)[lane + 64 * j] = o; }
}

__device__ __forceinline__ int crow(int r, int hi) { return (r & 3) + 8 * (r >> 2) + 4 * hi; }
#define MFMA32(a, b, c) __builtin_amdgcn_mfma_f32_32x32x16_bf16((a), (b), (c), 0, 0, 0)
__device__ __forceinline__ void load_k(bf16x8 (&kf)[8], const bf16_t* __restrict__ Kb, int a, int lane) {
#pragma unroll
    for (int blk = 0; blk < 2; ++blk)
#pragma unroll
        for (int d0 = 0; d0 < 4; ++d0) kf[blk * 4 + d0] = *(const bf16x8*)(Kb + (size_t)(2 * a + blk) * 2048 + d0 * 512 + lane * 8);
}
__device__ __forceinline__ void load_v(bf16x8 (&vf)[8], const bf16_t* __restrict__ Vb, int a, int lane) {
#pragma unroll
    for (int g4 = 0; g4 < 4; ++g4)
#pragma unroll
        for (int d0 = 0; d0 < 2; ++d0) vf[g4 * 2 + d0] = *(const bf16x8*)(Vb + (size_t)((4 * a + g4) * 2 + d0) * 512 + lane * 8);
}
__device__ __forceinline__ bf16x8 pack8(const float (&A)[32], int base) {
    u32x4 w; w.x = pk2(A[base], A[base + 1]); w.y = pk2(A[base + 2], A[base + 3]); w.z = pk2(A[base + 4], A[base + 5]); w.w = pk2(A[base + 6], A[base + 7]);
    return __builtin_bit_cast(bf16x8, w);
}
__device__ __forceinline__ void pv_acc(f32x16 (&o)[2], const float (&A)[32], const bf16x8 (&vf)[8]) {
#pragma unroll
    for (int g4 = 0; g4 < 4; ++g4) { const bf16x8 pa = pack8(A, 8 * g4); o[0] = MFMA32(pa, vf[g4 * 2], o[0]); o[1] = MFMA32(pa, vf[g4 * 2 + 1], o[1]); }
}
__device__ __forceinline__ void qk_tile(float (&z)[32], const bf16x8 (&kf)[8], const bf16x8 (&qr)[4]) {
    f32x16 p0 = {}, p1 = {};
#pragma unroll
    for (int d0 = 0; d0 < 4; ++d0) { p0 = MFMA32(kf[d0], qr[d0], p0); p1 = MFMA32(kf[4 + d0], qr[d0], p1); }
#pragma unroll
    for (int r = 0; r < 16; ++r) { z[r] = p0[r]; z[16 + r] = p1[r]; }
}
template <int BLK> __device__ __forceinline__ void sb_block(f32x16 (&o)[2], float& carry, const f32x16& p, const bf16x8 (&vf)[8], int a, bool diag, int qpos, int hi) {
    float u[16], be[16];
#pragma unroll
    for (int i = 0; i < 16; ++i) { const float e = __builtin_amdgcn_exp2f(fminf(p[i], 126.f)); const float uu = __builtin_amdgcn_rcpf(1.0f + e); u[i] = uu; be[i] = e * uu; }
    if (diag) {
#pragma unroll
        for (int i = 0; i < 16; ++i) { const int key = 64 * a + 32 * BLK + crow(i, hi); if (key >= qpos) { u[i] = 1.f; be[i] = 0.f; } }
    }
    float X[16], T[4], oth[4], PS[4], SS[4];
#pragma unroll
    for (int k = 0; k < 4; ++k) { const float x2 = u[4 * k + 3], x1 = x2 * u[4 * k + 2], x0 = x1 * u[4 * k + 1]; X[4 * k + 3] = 1.f; X[4 * k + 2] = x2; X[4 * k + 1] = x1; X[4 * k] = x0; T[k] = x0 * u[4 * k]; }
#pragma unroll
    for (int k = 0; k < 4; ++k) { oth[k] = __shfl_xor(T[k], 32); PS[k] = T[k] * oth[k]; }
    SS[3] = carry;
#pragma unroll
    for (int k = 2; k >= 0; --k) SS[k] = SS[k + 1] * PS[k + 1];
    carry = SS[0] * PS[0];
    float A[16];
#pragma unroll
    for (int k = 0; k < 4; ++k) { const float R = hi ? SS[k] : SS[k] * oth[k];
        A[4 * k + 3] = be[4 * k + 3] * R; A[4 * k + 2] = be[4 * k + 2] * (X[4 * k + 2] * R); A[4 * k + 1] = be[4 * k + 1] * (X[4 * k + 1] * R); A[4 * k] = be[4 * k] * (X[4 * k] * R); }
#pragma unroll
    for (int j = 0; j < 2; ++j) { u32x4 w; w.x = pk2(A[8 * j], A[8 * j + 1]); w.y = pk2(A[8 * j + 2], A[8 * j + 3]); w.z = pk2(A[8 * j + 4], A[8 * j + 5]); w.w = pk2(A[8 * j + 6], A[8 * j + 7]);
        const bf16x8 pa = __builtin_bit_cast(bf16x8, w); o[0] = MFMA32(pa, vf[(2 * BLK + j) * 2], o[0]); o[1] = MFMA32(pa, vf[(2 * BLK + j) * 2 + 1], o[1]); }
}
__device__ __forceinline__ void sb_tile(f32x16 (&o)[2], float& carry, const bf16x8 (&kf)[8], const bf16x8 (&vf)[8], const bf16x8 (&qr)[4], int a, bool diag, int qpos, int hi) {
    f32x16 p0 = {}, p1 = {};
#pragma unroll
    for (int d0 = 0; d0 < 4; ++d0) { p1 = MFMA32(kf[4 + d0], qr[d0], p1); p0 = MFMA32(kf[d0], qr[d0], p0); }
    sb_block<1>(o, carry, p1, vf, a, diag, qpos, hi);
    sb_block<0>(o, carry, p0, vf, a, diag, qpos, hi);
}
__device__ __forceinline__ void store_o(const f32x16 (&o)[2], bf16_t* Yp  , float* ssqp  , LAS unsigned char* stg, int lane) {
    const int dl = lane & 31, hi = lane >> 5;
    LAS bf16_t* st = (LAS bf16_t*)stg;
#pragma unroll
    for (int d0 = 0; d0 < 2; ++d0)
#pragma unroll
        for (int r = 0; r < 16; ++r) { const unsigned w = pk2(o[d0][r], 0.f); st[crow(r, hi) * 64 + d0 * 32 + dl] = (bf16_t)(w & 0xffffu); }
    asm volatile("s_waitcnt lgkmcnt(0)" ::: "memory");
#pragma unroll
    for (int i = 0; i < 4; ++i) { const int row = i * 8 + (lane >> 3), ch = lane & 7; const u32x4 v = *(const LAS u32x4*)(st + row * 64 + ch * 8); *(u32x4*)(Yp + (size_t)row * 2048 + ch * 8) = v;
        float s = 0.f;
#pragma unroll
        for (int e = 0; e < 4; ++e) { const float a = bf_lo(v[e]), b = bf_hi(v[e]); s += a * a + b * b; }
        s += __shfl_xor(s, 1); s += __shfl_xor(s, 2); s += __shfl_xor(s, 4);
        if (ch == 0) __hip_atomic_fetch_add(ssqp + 2 * row, s, __ATOMIC_RELAXED, __HIP_MEMORY_SCOPE_AGENT); }
    asm volatile("s_waitcnt lgkmcnt(0)" ::: "memory");
}
__device__ __forceinline__ void load_kb(bf16x8 (&kf)[4], const bf16_t* __restrict__ Kb, int kb, int lane) {
#pragma unroll
    for (int d0 = 0; d0 < 4; ++d0) kf[d0] = *(const bf16x8*)(Kb + (size_t)kb * 2048 + d0 * 512 + lane * 8);
}
__device__ __forceinline__ void load_vb(bf16x8 (&vf)[4], const bf16_t* __restrict__ Vb, int kb, int lane) {
#pragma unroll
    for (int j = 0; j < 2; ++j)
#pragma unroll
        for (int d0 = 0; d0 < 2; ++d0) vf[j * 2 + d0] = *(const bf16x8*)(Vb + (size_t)((2 * kb + j) * 2 + d0) * 512 + lane * 8);
}
__device__ __forceinline__ void pv_block(f32x16 (&o)[2], const f32x16& p, const bf16x8 (&vf)[4]) {
#pragma unroll
    for (int j = 0; j < 2; ++j) { u32x4 w; w.x = pk2(p[8 * j], p[8 * j + 1]); w.y = pk2(p[8 * j + 2], p[8 * j + 3]); w.z = pk2(p[8 * j + 4], p[8 * j + 5]); w.w = pk2(p[8 * j + 6], p[8 * j + 7]);
        const bf16x8 pa = __builtin_bit_cast(bf16x8, w); o[0] = MFMA32(pa, vf[j * 2], o[0]); o[1] = MFMA32(pa, vf[j * 2 + 1], o[1]); }
}
__device__ __forceinline__ void sb_item(int b, int h, int c, const bf16_t* __restrict__ Q, const bf16_t* __restrict__ KF, const bf16_t* __restrict__ VF, bf16_t* Y, float* ssqy, LAS unsigned char* stg, int lane) {
    const int r32 = lane & 31, hi = lane >> 5, q0 = 32 * c, qpos = q0 + r32;
    const bf16_t* Qrow = Q + (size_t)(b * SEQ + qpos) * 2048 + 1024 + h * 64;
    bf16x8 qr[4];
#pragma unroll
    for (int d0 = 0; d0 < 4; ++d0) qr[d0] = *(const bf16x8*)(Qrow + d0 * 16 + hi * 8);
    const bf16_t* Kb = KF + (size_t)(b * NKVH + 4 + h) * 131072; const bf16_t* Vb = VF + (size_t)(b * NKVH + 4 + h) * 131072;
    f32x16 o[2]; o[0] = f32x16{}; o[1] = f32x16{};
    float carry = 1.f;
    bf16x8 kc[4], kn[4], vc[4], vn[4];
    int kb = c;
    load_kb(kc, Kb, kb, lane); load_vb(vc, Vb, kb, lane);
#pragma unroll 1
    for (;;) {
        const int kp = kb > 0 ? kb - 1 : 0;
        load_kb(kn, Kb, kp, lane); load_vb(vn, Vb, kp, lane);
        f32x16 p = {};
#pragma unroll
        for (int d0 = 0; d0 < 4; ++d0) p = MFMA32(kc[d0], qr[d0], p);
        float u[16], be[16];
#pragma unroll
        for (int i = 0; i < 16; ++i) { const float e = __builtin_amdgcn_exp2f(fminf(p[i], 126.f)); const float uu = __builtin_amdgcn_rcpf(1.0f + e); u[i] = uu; be[i] = e * uu; }
        if (kb == c) {
#pragma unroll
            for (int i = 0; i < 16; ++i) { if (crow(i, hi) >= r32) { u[i] = 1.f; be[i] = 0.f; } }
        }
        float X[16], T[4], oth[4], PS[4], SS[4];
#pragma unroll
        for (int k = 0; k < 4; ++k) { const float x2 = u[4 * k + 3], x1 = x2 * u[4 * k + 2], x0 = x1 * u[4 * k + 1]; X[4 * k + 3] = 1.f; X[4 * k + 2] = x2; X[4 * k + 1] = x1; X[4 * k] = x0; T[k] = x0 * u[4 * k]; }
#pragma unroll
        for (int k = 0; k < 4; ++k) { oth[k] = __shfl_xor(T[k], 32); PS[k] = T[k] * oth[k]; }
        SS[3] = carry;
#pragma unroll
        for (int k = 2; k >= 0; --k) SS[k] = SS[k + 1] * PS[k + 1];
        carry = SS[0] * PS[0];
#pragma unroll
        for (int k = 0; k < 4; ++k) { const float R = hi ? SS[k] : SS[k] * oth[k];
            p[4 * k + 3] = be[4 * k + 3] * R; p[4 * k + 2] = be[4 * k + 2] * (X[4 * k + 2] * R); p[4 * k + 1] = be[4 * k + 1] * (X[4 * k + 1] * R); p[4 * k] = be[4 * k] * (X[4 * k] * R); }
        pv_block(o, p, vc);
        if (kb == 0) break;
        if (__all(carry < 1.17549435e-38f)) break;
        --kb;
#pragma unroll
        for (int i = 0; i < 4; ++i) { kc[i] = kn[i]; vc[i] = vn[i]; }
    }
    store_o(o, Y + (size_t)(b * SEQ + q0) * 2048 + 1024 + h * 64, ssqy + (size_t)(b * SEQ + q0) * 2 + 1, stg, lane);
}
__device__ __forceinline__ void swa_item(int b, int h, int c, const bf16_t* __restrict__ Q, const bf16_t* __restrict__ KF, const bf16_t* __restrict__ VF, bf16_t* Y, float* ssqy, float sink2, float slope2, LAS unsigned char* stg, int lane) {
    const int r32 = lane & 31, hi = lane >> 5, q0 = 32 * c, qpos = q0 + r32, kv = h >> 2;
    const bf16_t* Qrow = Q + (size_t)(b * SEQ + qpos) * 2048 + h * 64;
    bf16x8 qr[4];
#pragma unroll
    for (int d0 = 0; d0 < 4; ++d0) qr[d0] = *(const bf16x8*)(Qrow + d0 * 16 + hi * 8);
    const bf16_t* Kb = KF + (size_t)(b * NKVH + kv) * 131072; const bf16_t* Vb = VF + (size_t)(b * NKVH + kv) * 131072;
    f32x16 o[2]; o[0] = f32x16{}; o[1] = f32x16{};
    float m = sink2, l = hi ? 0.f : 1.f;
    const int klo = c >= 4 ? c - 4 : 0;
    bf16x8 kc[4], kn[4], vc[4], vn[4];
    int kb = c;
    load_kb(kc, Kb, kb, lane); load_vb(vc, Vb, kb, lane);
#pragma unroll 1
    for (;;) {
        const int kp = kb > klo ? kb - 1 : klo;
        load_kb(kn, Kb, kp, lane); load_vb(vn, Vb, kp, lane);
        f32x16 p = {};
#pragma unroll
        for (int d0 = 0; d0 < 4; ++d0) p = MFMA32(kc[d0], qr[d0], p);
        const float dbase = (float)(qpos - 32 * kb - 4 * hi), sbase = slope2 * dbase;
#pragma unroll
        for (int r = 0; r < 16; ++r) p[r] = __builtin_fmaf(slope2, (float)((r & 3) + 8 * (r >> 2)), p[r]) - sbase;
        if (kb == c) {
#pragma unroll
            for (int r = 0; r < 16; ++r) p[r] = ((float)((r & 3) + 8 * (r >> 2)) <= dbase) ? p[r] : -INFINITY;
        } else if (kb + 4 == c) {
            const float dlim = dbase - 128.f;
#pragma unroll
            for (int r = 0; r < 16; ++r) p[r] = ((float)((r & 3) + 8 * (r >> 2)) > dlim) ? p[r] : -INFINITY;
        }
        float r0 = fmaxf(p[0], p[1]), r1 = fmaxf(p[2], p[3]);
#pragma unroll
        for (int r = 4; r < 16; r += 4) { r0 = fmaxf(r0, fmaxf(p[r], p[r + 1])); r1 = fmaxf(r1, fmaxf(p[r + 2], p[r + 3])); }
        float rm = fmaxf(r0, r1);
        rm = fmaxf(rm, __shfl_xor(rm, 32));
        if (__any(rm > m)) {
            const float mn = fmaxf(m, rm), f = __builtin_amdgcn_exp2f(m - mn); m = mn; l *= f;
#pragma unroll
            for (int r = 0; r < 16; ++r) { const float fr_ = __shfl(f, crow(r, hi)); o[0][r] *= fr_; o[1][r] *= fr_; }
        }
        float l0 = 0.f, l1 = 0.f;
#pragma unroll
        for (int r = 0; r < 16; r += 2) { p[r] = __builtin_amdgcn_exp2f(p[r] - m); p[r + 1] = __builtin_amdgcn_exp2f(p[r + 1] - m); l0 += p[r]; l1 += p[r + 1]; }
        l += l0 + l1;
        pv_block(o, p, vc);
        if (kb == klo) break;
        --kb;
#pragma unroll
        for (int i = 0; i < 4; ++i) { kc[i] = kn[i]; vc[i] = vn[i]; }
    }
    l += __shfl_xor(l, 32);
    const float inv = 1.0f / l;
#pragma unroll
    for (int r = 0; r < 16; ++r) { const float ir = __shfl(inv, crow(r, hi)); o[0][r] *= ir; o[1][r] *= ir; }
    store_o(o, Y + (size_t)(b * SEQ + q0) * 2048 + h * 64, ssqy + (size_t)(b * SEQ + q0) * 2, stg, lane);
}

#define XB_TMO      128
#define XB_XCNT(j)  (256  + 64 * (j))
#define XB_XSUB(j)  (1280 + 64 * (j))
#define XB_XGEN(j)  (2304 + 64 * (j))
#define XB_TOP      3328
#define XB_TOPGEN   3392
#define XCD_BAR_WORDS 3456
#define XB_SPIN_CAP (1u << 18)

__device__ __forceinline__ unsigned xb_ld(unsigned* p)              { return __hip_atomic_load(p, __ATOMIC_RELAXED, __HIP_MEMORY_SCOPE_AGENT); }
__device__ __forceinline__ unsigned xb_add(unsigned* p, unsigned v) { return __hip_atomic_fetch_add(p, v, __ATOMIC_RELAXED, __HIP_MEMORY_SCOPE_AGENT); }
__device__ __forceinline__ unsigned xb_xcc_id() { return (unsigned)__builtin_amdgcn_s_getreg((3 << 11) | 20) & 0xFu; }
#define XB_SPIN(cond, bar) do { unsigned _sp = 0; while (cond) { __builtin_amdgcn_s_sleep(1); \
    if ((++_sp & 255u) == 0u) { if (xb_ld(&(bar)[XB_TMO])) break; if (_sp > XB_SPIN_CAP) { atomicAdd(&(bar)[XB_TMO], 1u); break; } } } } while (0)

struct XcdBarrier {
    unsigned* bar; unsigned x;
    volatile LAS unsigned* st;
};

__device__ __forceinline__ XcdBarrier xcd_barrier_post(unsigned* bar, volatile LAS unsigned* st, const bool t0  ) {
    XcdBarrier b; b.bar = bar; b.x = xb_xcc_id(); b.st = st;
    if (t0) (void)xb_add(&bar[XB_XCNT(b.x)], 1u);
    return b;
}
__device__ __forceinline__ void xcd_barrier_complete(unsigned* bar, unsigned x, unsigned& nloc, unsigned& nx) {
    const unsigned G = gridDim.x * gridDim.y * gridDim.z;
    unsigned sum, cnt, mine, sp = 0u;
    for (;;) {
        sum = 0u; cnt = 0u; mine = 0u;
#pragma unroll
        for (unsigned j = 0; j < 16; ++j) { const unsigned c = xb_ld(&bar[XB_XCNT(j)]); sum += c; cnt += (c > 0u) ? 1u : 0u; mine = (j == x) ? c : mine; }
        if (sum == G) break;
        __builtin_amdgcn_s_sleep(1);
        if ((++sp & 255u) == 0u) { if (xb_ld(&bar[XB_TMO])) break; if (sp > XB_SPIN_CAP) { atomicAdd(&bar[XB_TMO], 1u); break; } }
    }
    nloc = mine > 0u ? mine : 1u; nx = cnt > 0u ? cnt : 1u;
}

__device__ __forceinline__ void xcd_barrier(const XcdBarrier& b, const bool t0  ) {
    asm volatile("s_waitcnt vmcnt(0)" ::: "memory");
    __syncthreads();
    if (t0) {
        unsigned* bar = b.bar;
        __builtin_amdgcn_s_waitcnt(0);
        unsigned nloc = b.st[0], nx = b.st[1];
        if (nloc == 0u) { xcd_barrier_complete(bar, b.x, nloc, nx); b.st[0] = nloc; b.st[1] = nx; }
        const unsigned old = xb_add(&bar[XB_XSUB(b.x)], 1u);
        const unsigned gen = old / nloc;
        if (old + 1u == (gen + 1u) * nloc) {
            __builtin_amdgcn_fence(__ATOMIC_RELEASE, "agent");
            asm volatile("s_waitcnt vmcnt(0)" ::: "memory");
            const unsigned og = xb_add(&bar[XB_TOP], 1u);
            const unsigned tg = og / nx;
            if (og + 1u == (tg + 1u) * nx) xb_add(&bar[XB_TOPGEN], 1u);
            else XB_SPIN(xb_ld(&bar[XB_TOPGEN]) == tg, bar);
            __builtin_amdgcn_fence(__ATOMIC_ACQUIRE, "agent");
            xb_add(&bar[XB_XGEN(b.x)], 1u);
            asm volatile("s_waitcnt vmcnt(0)" ::: "memory");
        } else {
            XB_SPIN(xb_ld(&bar[XB_XGEN(b.x)]) == gen, bar);
            __builtin_amdgcn_fence(__ATOMIC_ACQUIRE, "agent");
            asm volatile("s_waitcnt vmcnt(0)" ::: "memory");
        }
    }
    __syncthreads();
}

__device__ __forceinline__ int fresh_lane() { return pg8::lane_id(); }
struct Args { const float* in[16]; float* out; unsigned char* ws; };
__global__ void __launch_bounds__(NWAVES * 64, 2) hybrid_fwd(Args args) {
    extern __shared__ __attribute__((aligned(16))) unsigned char lds_raw[];
    LAS unsigned char* lds = (LAS unsigned char*)lds_raw;
    cg::grid_group grid = cg::this_grid();
    const int wave = __builtin_amdgcn_readfirstlane((int)threadIdx.x >> 6);
#define T0() (wave == 0 && pg8::lane_id() == 0)
    volatile LAS unsigned* bst = (volatile LAS unsigned*)(lds + LDS_STAGE);
    if (wave == 0) { const int l_ = pg8::lane_id(); if (l_ < 2) bst[l_] = 0u; }
    __syncthreads();
    const XcdBarrier xbar = xcd_barrier_post((unsigned*)(args.ws + WS_CTL), bst, T0());
    const int G = gridDim.x, gw = blockIdx.x * NWAVES + wave, NGW = G * NWAVES;
    unsigned char* ws = args.ws;
    const float* x = args.in[0];
    float* out = args.out;
    bf16_t* WGU1 = (bf16_t*)(ws + WS_WGU1); bf16_t* WD1 = (bf16_t*)(ws + WS_WD1); bf16_t* WIN = (bf16_t*)(ws + WS_WIN); bf16_t* WOUT = (bf16_t*)(ws + WS_WOUT);
    bf16_t* WGU2 = (bf16_t*)(ws + WS_WGU2); bf16_t* WD2 = (bf16_t*)(ws + WS_WD2);
    bf16_t* HN = (bf16_t*)(ws + WS_HN); bf16_t* HB = (bf16_t*)(ws + WS_H); bf16_t* QB = (bf16_t*)(ws + WS_Q); bf16_t* KF = (bf16_t*)(ws + WS_KF); bf16_t* VF = (bf16_t*)(ws + WS_VF);
    bf16_t* YB = (bf16_t*)(ws + WS_Y);
    float* ssq1 = (float*)(ws + WS_SSQ); float* ssq2 = ssq1 + MTOK; float* ssqy = ssq2 + MTOK; float* ssq3 = ssqy + 2 * MTOK;
    unsigned char* X2F8 = ws + WS_X2F8; bf16_t* X2B = (bf16_t*)(ws + WS_X2B);

    {
        const int lane = pg8::lane_id(), tid = wave * 64 + lane;
        constexpr int I_GU = 43 * 32, I_DN = 16 * 86, I_IN = 36 * 32, I_OUT = 16 * 32;
        constexpr int NITEMS = 4 * I_GU + 2 * I_DN + I_IN + I_OUT;
        for (int it = gw; it < NITEMS; it += NGW) {
            int r = it;
            if (r < I_GU) { transpose_item(args.in[2], DM, DFF, WGU1, 1, r, lane); continue; } r -= I_GU;
            if (r < I_GU) { transpose_item(args.in[3], DM, DFF, WGU1, 2, r, lane); continue; } r -= I_GU;
            if (r < I_DN) { transpose_item(args.in[4], DFF, DM, WD1, 0, r, lane, nullptr, nullptr, 0, DFF / 64); continue; } r -= I_DN;
            if (r < I_IN) { transpose_item(args.in[6], DM, 4608, WIN, 3, r, lane, args.in[5]); continue; } r -= I_IN;
            if (r < I_OUT) { transpose_item(args.in[10], DM, DM, WOUT, 0, r, lane, args.in[8], args.in[9]); continue; } r -= I_OUT;
            if (r < I_GU) { transpose_item<true>(args.in[12], DM, DFF, WGU2, 1, r, lane, args.in[11]); continue; } r -= I_GU;
            if (r < I_GU) { transpose_item<true>(args.in[13], DM, DFF, WGU2, 2, r, lane, args.in[11]); continue; } r -= I_GU;
            transpose_item(args.in[14], DFF, DM, WD2, 0, r, lane, nullptr, nullptr, 0, DFF / 64);
        }
        for (int m = gw; m < MTOK; m += NGW) rms_row_bf16(x + (size_t)m * DM, args.in[1], HN + (size_t)m * DM, lane);
        for (int i = blockIdx.x * (NWAVES * 64) + tid; i < 5 * MTOK; i += G * NWAVES * 64) ssq1[i] = 0.f;
    }
    if (args.ws == nullptr) grid.sync();
    xcd_barrier(xbar, T0());
    {
        pg8::Gemm g{HN, WGU1, MTOK, 2 * DFF, DM, DM, 0}; pg8::StaticOrder S; S.init(MTOK, 2 * DFF, G, (int)blockIdx.x);
        pg8::EpiSwiglu E{HB, LDH, nullptr, 1.0f, DFF / 64};
        pg8::gemm_phase<pg8::EpiSwiglu, pg8::StaticOrder, true, true>(lds, g, S, E, wave);
    }
    xcd_barrier(xbar, T0());
    {
        pg8::Gemm g{HB, WD1, MTOK, DM, DFF, LDH, 2}; pg8::StaticOrder S; S.init(MTOK, DM, G, (int)blockIdx.x, 1);
        pg8::EpiResidStat<false, false, false, true, false> E{x, nullptr, HN, nullptr, ssq1, 0.5f, nullptr};
        pg8::gemm_phase<pg8::EpiResidStat<false, false, false, true, false>, pg8::StaticOrder, true, true>(lds, g, S, E, wave);
    }
    xcd_barrier(xbar, T0());
    {
        pg8::Gemm g{HN, WIN, MTOK, NQK, DM, DM, 0}; pg8::InProjOrder S; S.init(MTOK, NQK, NVT, G, (int)blockIdx.x, HN, WIN, DM);
        pg8::EpiInProj E{pg8::EpiQK{QB, KF, QSCALE, ssq1}, pg8::EpiVT{VF, ssq1}};
        pg8::gemm_phase<pg8::EpiInProj, pg8::InProjOrder, true, true>(lds, g, S, E, wave);
    }
    xcd_barrier(xbar, T0());
    { const int lane5 = fresh_lane();
    for (int pi = gw; pi < NBATCH * 16 * 8; pi += NGW) {
        const int bh = pi >> 3, s = pi & 7, b = bh >> 4, h = bh & 15;
#pragma unroll 1
        for (int i = 0; i < 8; ++i) { const int c = 16 * (i >> 1) + ((i & 1) ? 15 - s : s); sb_item(b, h, c, QB, KF, VF, YB, ssqy, lds + wave * 4096, lane5); }
        const float sink2 = args.in[7][h] * LOG2E, slope2 = __builtin_amdgcn_exp2f(-0.5f * (float)(h + 1)) * LOG2E;
#pragma unroll 1
        for (int i = 0; i < 8; ++i) { const int c = 16 * (i >> 1) + ((i & 1) ? 15 - s : s); swa_item(b, h, c, QB, KF, VF, YB, ssqy, sink2, slope2, lds + wave * 4096, lane5); }
    }
    }
    xcd_barrier(xbar, T0());
    {
        pg8::Gemm g{YB, WOUT, MTOK, DM, DM, DM, 0}; pg8::StaticOrder S; S.init(MTOK, DM, G, (int)blockIdx.x);
        pg8::EpiResidStat<true, true, false, true, true> E{HN, nullptr, X2B, X2F8, ssq2, 1.0f, ssqy};
        pg8::gemm_phase<pg8::EpiResidStat<true, true, false, true, true>, pg8::StaticOrder, true, true>(lds, g, S, E, wave);
    }
    xcd_barrier(xbar, T0());
    {
        pg8::Gemm g{(const bf16_t*)X2F8, WGU2, MTOK, 2 * DFF, DM / 2, DM / 2, 0}; pg8::StaticOrder S; S.init(MTOK, 2 * DFF, G, (int)blockIdx.x);
        pg8::EpiSwiglu E{HB, LDH, ssq2, 1.0f / W8_SCALE, DFF / 64};
        pg8::gemm_phase<pg8::EpiSwiglu, pg8::StaticOrder, true, true, true>(lds, g, S, E, wave);
    }
    xcd_barrier(xbar, T0());
    {
        pg8::Gemm g{HB, WD2, MTOK, DM, DFF, LDH, 2}; pg8::StaticOrder S; S.init(MTOK, DM, G, (int)blockIdx.x, 1);
        pg8::EpiResidStat<false, true, false, true, false> E{X2B, nullptr, HN, nullptr, ssq3, 0.5f, nullptr};
        pg8::gemm_phase<pg8::EpiResidStat<false, true, false, true, false>, pg8::StaticOrder, true, true>(lds, g, S, E, wave);
    }
    xcd_barrier(xbar, T0());
    { const int lane11 = fresh_lane();
    for (int m = gw; m < MTOK; m += NGW) final_row(HN + (size_t)m * DM, ssq3[m], args.in[15], out + (size_t)m * DM, lane11); }
}

extern "C" void kernel_launch(void* const* d_in, const int* in_sizes, int n_in, void* d_out, int out_size, void* d_ws, size_t ws_size, hipStream_t stream) {
    static int grid_blocks = 0;
    if (grid_blocks == 0) {
        if (n_in != 16 || in_sizes[0] != MTOK * DM || out_size != MTOK * DM || ws_size < WS_END) {
            fprintf(stderr, "kernel_launch: unexpected shapes (n_in %d in0 %d out %d ws %zu)\n", n_in, n_in > 0 ? in_sizes[0] : -1, out_size, ws_size); grid_blocks = -1; return; }
        int dev = 0, cus = 0, per_cu = 0;
        hipGetDevice(&dev);
        hipDeviceGetAttribute(&cus, hipDeviceAttributeMultiprocessorCount, dev);
        hipFuncSetAttribute((const void*)hybrid_fwd, hipFuncAttributeMaxDynamicSharedMemorySize, LDS_BYTES);
        hipOccupancyMaxActiveBlocksPerMultiprocessor(&per_cu, (const void*)hybrid_fwd, NWAVES * 64, LDS_BYTES);
        if (per_cu < 1) { fprintf(stderr, "kernel_launch: occupancy query says %d blocks/CU\n", per_cu); per_cu = 1; }
        grid_blocks = cus * per_cu;
    }
    if (grid_blocks < 0) return;
    if (hipMemsetAsync((char*)d_ws + WS_CTL, 0, CTL_BYTES, stream) != hipSuccess) { fprintf(stderr, "kernel_launch: hipMemsetAsync failed\n"); return; }
    Args a{};
    for (int i = 0; i < 16; ++i) a.in[i] = (const float*)d_in[i];
    a.out = (float*)d_out; a.ws = (unsigned char*)d_ws;
    void* kargs[] = {&a};
    hipError_t e = hipLaunchCooperativeKernel((const void*)hybrid_fwd, dim3(grid_blocks), dim3(NWAVES * 64), kargs, LDS_BYTES, stream);
    if (e != hipSuccess) fprintf(stderr, "cooperative launch failed: %s (grid %d)\n", hipGetErrorString(e), grid_blocks);
}
```
